# Optimizing an MI355X kernel written in HIP

```python
import jax, jax.numpy as jnp
from jax import lax
import numpy as np

D_MODEL = 2048
BATCH = 4
SEQ = 2048
DEPTH = 1
DEC_BATCH = 128
DEC_SEQ = 8
PAST_LEN = 16384
PAGE_SIZE = 128

D_MIX = D_MODEL
D_A = D_MIX // 2
A_HEADS = 8
A_EXPAND = 128
A_VDIM = D_A // A_HEADS
FORGET_DIM = A_HEADS * A_EXPAND
C_CONV = D_MIX - D_A
CONV_W = 31
CHUNK = 64
D_FF = 5632
MEM_LEN = 256
XA_HEADS = 4
XA_HDIM = 128
XA_DIM = XA_HEADS * XA_HDIM
D_IN = 2 * FORGET_DIM + 2 * D_A + 2 * C_CONV
EPS = 1e-6
FFN_RES = 0.5

kernel_name = 'hymba_hgrn2_conformer_macaron_step'


def rmsnorm(x, g):
    xf = x.astype(jnp.float32)
    y = xf * lax.rsqrt(jnp.mean(xf * xf, axis=-1, keepdims=True) + EPS)
    return (y * g.astype(jnp.float32)).astype(x.dtype)


def swiglu_ffn(x, wg, wu, wd):
    return (jax.nn.silu(x @ wg) * (x @ wu)) @ wd


def hgrn2_recurrence(q, k, logf, v, s0):
    N, L, H, E = q.shape
    DV = v.shape[-1]
    C = CHUNK if L % CHUNK == 0 else L
    nc = L // C

    def to_chunks(a):
        return a.reshape(N, nc, C, H, a.shape[-1]).transpose(1, 0, 3, 2, 4)

    causal = jnp.tril(jnp.ones((C, C), dtype=bool))[None, None, :, :, None]

    def step(S, inp):
        qc, kc, fc, vc = inp
        b = jnp.cumsum(fc, axis=2)
        decay = jnp.exp(jnp.where(causal, b[:, :, :, None, :] - b[:, :, None, :, :], -jnp.inf))
        A = jnp.einsum('nhte,nhtse,nhse->nhts', qc, decay, kc)
        o = jnp.einsum('nhts,nhsd->nhtd', A, vc) + jnp.einsum('nhte,nhed->nhtd', qc * jnp.exp(b), S)
        b_end = b[:, :, -1, :]
        k_to_end = kc * jnp.exp(b_end[:, :, None, :] - b)
        S = jnp.exp(b_end)[..., None] * S + jnp.einsum('nhse,nhsd->nhed', k_to_end, vc)
        return S, o

    S, o = lax.scan(step, s0, (to_chunks(q), to_chunks(k), to_chunks(logf), to_chunks(v)))
    o = o.transpose(1, 0, 3, 2, 4).reshape(N, L, H, DV)
    return o, S


def mixer(h, s0, buf0, lb, w_in, gnorm, conv_w, conv_b, ln_g, ln_b, w_out):
    N, L, _ = h.shape
    f32 = jnp.float32
    z = h @ w_in
    idx = [FORGET_DIM, 2 * FORGET_DIM, 2 * FORGET_DIM + D_A, 2 * FORGET_DIM + 2 * D_A,
           2 * FORGET_DIM + 2 * D_A + C_CONV]
    zq, zf, zi, zg, za, zb = jnp.split(z, idx, axis=-1)
    q = jax.nn.silu(zq.astype(f32)).reshape(N, L, A_HEADS, A_EXPAND)
    f = lb + (1.0 - lb) * jax.nn.sigmoid(zf.astype(f32))
    logf = jnp.log(f).reshape(N, L, A_HEADS, A_EXPAND)
    k = (1.0 - f).reshape(N, L, A_HEADS, A_EXPAND)
    v = zi.astype(f32).reshape(N, L, A_HEADS, A_VDIM)
    o, s_new = hgrn2_recurrence(q, k, logf, v, s0.astype(f32))
    o = rmsnorm(o, gnorm) * jax.nn.silu(zg.astype(f32).reshape(N, L, A_HEADS, A_VDIM))
    o_a = o.reshape(N, L, D_A)
    u = za.astype(f32) * jax.nn.sigmoid(zb.astype(f32))
    ucat = jnp.concatenate([buf0.astype(f32), u], axis=1)
    buf_new = ucat[:, ucat.shape[1] - (CONV_W - 1):]
    dw = lax.conv_general_dilated(ucat, conv_w.astype(f32)[:, None, :], (1,), 'VALID',
                                  dimension_numbers=('NWC', 'WIO', 'NWC'),
                                  feature_group_count=C_CONV) + conv_b.astype(f32)
    mu = jnp.mean(dw, axis=-1, keepdims=True)
    var = jnp.mean(jnp.square(dw - mu), axis=-1, keepdims=True)
    ln = (dw - mu) * lax.rsqrt(var + EPS) * ln_g.astype(f32) + ln_b.astype(f32)
    o_b = jax.nn.silu(ln)
    out = jnp.concatenate([o_a, o_b], axis=-1).astype(h.dtype) @ w_out
    return out, s_new.astype(s0.dtype), buf_new.astype(buf0.dtype)


def mem_kv(mem, g, wk, wv):
    N, M, _ = mem.shape
    mn = rmsnorm(mem, g)
    return (mn @ wk).reshape(N, M, XA_HEADS, XA_HDIM), (mn @ wv).reshape(N, M, XA_HEADS, XA_HDIM)


def cross_attn(h, mk, mv, wq, wo):
    N, L, _ = h.shape
    q = (h @ wq).reshape(N, L, XA_HEADS, XA_HDIM)
    s = jnp.einsum('nlhd,nmhd->nhlm', q.astype(jnp.float32), mk.astype(jnp.float32)) * (XA_HDIM ** -0.5)
    p = jax.nn.softmax(s, axis=-1)
    o = jnp.einsum('nhlm,nmhd->nlhd', p, mv.astype(jnp.float32)).reshape(N, L, XA_DIM)
    return o.astype(h.dtype) @ wo


def block(x, mk, mv, s0, buf0, lb, p):
    (n_f1, f1_g, f1_u, f1_d, n_mix, w_in, gnorm, conv_w, conv_b, ln_g, ln_b, w_out,
     n_xa, xa_q, xa_o, n_f2, f2_g, f2_u, f2_d) = p
    x = x + FFN_RES * swiglu_ffn(rmsnorm(x, n_f1), f1_g, f1_u, f1_d)
    m, s_new, buf_new = mixer(rmsnorm(x, n_mix), s0, buf0, lb, w_in, gnorm, conv_w, conv_b, ln_g, ln_b, w_out)
    x = x + m
    x = x + cross_attn(rmsnorm(x, n_xa), mk, mv, xa_q, xa_o)
    x = x + FFN_RES * swiglu_ffn(rmsnorm(x, n_f2), f2_g, f2_u, f2_d)
    return x, s_new, buf_new


def setup_inputs(seed: int = 0) -> dict:
    key = jax.random.key(seed)
    ks = iter(jax.random.split(key, 48))

    def nrm(shape, scale):
        return scale * jax.random.normal(next(ks), shape, jnp.float32)

    def gain(shape):
        return 1.0 + nrm(shape, 0.05)

    return {
        'x_prompt': nrm((BATCH, SEQ, D_MODEL), 1.0),
        'x_sample': nrm((DEC_BATCH, DEC_SEQ, D_MODEL), 1.0),
        'mem_prompt': nrm((BATCH, MEM_LEN, D_MODEL), 1.0),
        'state_hgrn': nrm((DEPTH, DEC_BATCH, A_HEADS, A_EXPAND, A_VDIM), 0.1),
        'state_conv': nrm((DEPTH, DEC_BATCH, CONV_W - 1, C_CONV), 0.5),
        'cache_mem_k': nrm((DEPTH, DEC_BATCH, MEM_LEN, XA_HEADS, XA_HDIM), 1.0),
        'cache_mem_v': nrm((DEPTH, DEC_BATCH, MEM_LEN, XA_HEADS, XA_HDIM), 1.0),
        'norm_ffn1': gain((DEPTH, D_MODEL)),
        'ffn1_w_gate': nrm((DEPTH, D_MODEL, D_FF), D_MODEL ** -0.5),
        'ffn1_w_up': nrm((DEPTH, D_MODEL, D_FF), D_MODEL ** -0.5),
        'ffn1_w_down': nrm((DEPTH, D_FF, D_MODEL), D_FF ** -0.5),
        'norm_mix': gain((DEPTH, D_MODEL)),
        'w_in': nrm((DEPTH, D_MODEL, D_IN), D_MODEL ** -0.5),
        'hgrn_lb': nrm((DEPTH + 1, FORGET_DIM), 0.5),
        'hgrn_gnorm': gain((DEPTH, A_VDIM)),
        'conv_w': nrm((DEPTH, CONV_W, C_CONV), CONV_W ** -0.5),
        'conv_b': nrm((DEPTH, C_CONV), 0.02),
        'conv_ln_g': gain((DEPTH, C_CONV)),
        'conv_ln_b': nrm((DEPTH, C_CONV), 0.02),
        'w_out': nrm((DEPTH, D_MIX, D_MODEL), D_MIX ** -0.5),
        'norm_xattn': gain((DEPTH, D_MODEL)),
        'norm_mem': gain((DEPTH, D_MODEL)),
        'xattn_wq': nrm((DEPTH, D_MODEL, XA_DIM), D_MODEL ** -0.5),
        'xattn_wk': nrm((DEPTH, D_MODEL, XA_DIM), D_MODEL ** -0.5),
        'xattn_wv': nrm((DEPTH, D_MODEL, XA_DIM), D_MODEL ** -0.5),
        'xattn_wo': nrm((DEPTH, XA_DIM, D_MODEL), XA_DIM ** -0.5),
        'norm_ffn2': gain((DEPTH, D_MODEL)),
        'ffn2_w_gate': nrm((DEPTH, D_MODEL, D_FF), D_MODEL ** -0.5),
        'ffn2_w_up': nrm((DEPTH, D_MODEL, D_FF), D_MODEL ** -0.5),
        'ffn2_w_down': nrm((DEPTH, D_FF, D_MODEL), D_FF ** -0.5),
        'norm_final': gain((D_MODEL,)),
    }


def reference(x_prompt, x_sample, mem_prompt, state_hgrn, state_conv, cache_mem_k, cache_mem_v,
              norm_ffn1, ffn1_w_gate, ffn1_w_up, ffn1_w_down,
              norm_mix, w_in, hgrn_lb, hgrn_gnorm, conv_w, conv_b, conv_ln_g, conv_ln_b, w_out,
              norm_xattn, norm_mem, xattn_wq, xattn_wk, xattn_wv, xattn_wo,
              norm_ffn2, ffn2_w_gate, ffn2_w_up, ffn2_w_down, norm_final):
    lb_all = jnp.cumsum(jax.nn.softmax(hgrn_lb.astype(jnp.float32), axis=0), axis=0)
    B = x_prompt.shape[0]
    xp, xs = x_prompt, x_sample
    sh_p, sc_p, mk_p, mv_p, sh_s, sc_s = [], [], [], [], [], []
    for l in range(DEPTH):
        p = (norm_ffn1[l], ffn1_w_gate[l], ffn1_w_up[l], ffn1_w_down[l],
             norm_mix[l], w_in[l], hgrn_gnorm[l], conv_w[l], conv_b[l], conv_ln_g[l], conv_ln_b[l], w_out[l],
             norm_xattn[l], xattn_wq[l], xattn_wo[l],
             norm_ffn2[l], ffn2_w_gate[l], ffn2_w_up[l], ffn2_w_down[l])
        lb = lb_all[l]
        mk, mv = mem_kv(mem_prompt, norm_mem[l], xattn_wk[l], xattn_wv[l])
        s0 = jnp.zeros((B, A_HEADS, A_EXPAND, A_VDIM), state_hgrn.dtype)
        b0 = jnp.zeros((B, CONV_W - 1, C_CONV), state_conv.dtype)
        xp, s_new, b_new = block(xp, mk, mv, s0, b0, lb, p)
        sh_p.append(s_new); sc_p.append(b_new); mk_p.append(mk.astype(cache_mem_k.dtype)); mv_p.append(mv.astype(cache_mem_v.dtype))
        xs, s_new, b_new = block(xs, cache_mem_k[l], cache_mem_v[l], state_hgrn[l], state_conv[l], lb, p)
        sh_s.append(s_new); sc_s.append(b_new)
    y_prompt = rmsnorm(xp, norm_final)
    y_sample = rmsnorm(xs, norm_final)
    return (y_prompt, y_sample, jnp.stack(sh_p), jnp.stack(sc_p), jnp.stack(mk_p), jnp.stack(mv_p),
            jnp.stack(sh_s), jnp.stack(sc_s))
```

```cpp
#include <hip/hip_runtime.h>
#include <cstdio>
#include <cstdint>
#ifndef MK_PER_PHASE
#define MK_PER_PHASE 1
#endif
#define GAS __attribute__((address_space(1)))
#define LAS __attribute__((address_space(3)))
typedef unsigned short bf16;
typedef unsigned v4u __attribute__((ext_vector_type(4)));
typedef float f32x4 __attribute__((ext_vector_type(4)));
typedef short bf16x8 __attribute__((ext_vector_type(8)));
typedef GAS unsigned gu32;
typedef GAS unsigned long long gu64;
#define RLX_AGENT __ATOMIC_RELAXED, __HIP_MEMORY_SCOPE_AGENT
#define LDS_WAIT() asm volatile("s_waitcnt lgkmcnt(0)" ::: "memory")
#define VM_WAIT() asm volatile("s_waitcnt vmcnt(0)" ::: "memory")
__device__ __forceinline__ unsigned long long rt() { return __builtin_amdgcn_s_memrealtime(); }
__device__ __forceinline__ unsigned f2bf(float f) { unsigned u = __builtin_bit_cast(unsigned, f); return (u + 0x7fffu + ((u >> 16) & 1u)) >> 16; }
__device__ __forceinline__ unsigned pk2(float lo, float hi) { return f2bf(lo) | (f2bf(hi) << 16); }
namespace pg8 {
#define PG8_LAS __attribute__((address_space(3)))
typedef unsigned short bf16_t;
typedef short bf16x8 __attribute__((ext_vector_type(8)));
typedef float f32x4 __attribute__((ext_vector_type(4)));
typedef unsigned u32x4 __attribute__((ext_vector_type(4)));
constexpr int BM = 256, BK = 64, HALF = 128, HTB = HALF * BK * 2  , STAGE_BYTES = 8 * HTB, NXCD = 8, WGM = 8;

__host__ __device__ __forceinline__ int lds_byte(int r, int c) { const int st = (r >> 4) * 2 + (c >> 5), rr = r & 15, cc = c & 31, ob = rr * 64 + cc * 2; return st * 1024 + (ob ^ (((ob >> 9) & 1) << 5)); }
__host__ __device__ __forceinline__ void stage_rc(int b, int& R, int& C) { const int st = b / 1024, sb = b % 1024, swz = sb ^ (((sb >> 9) & 1) << 5); R = (st >> 1) * 16 + swz / 64; C = (st & 1) * 32 + (swz % 64) / 2; }
__host__ __device__ __forceinline__ int perm32(int rho) { const int n = rho >> 4, i = rho & 15; return 8 * (i >> 2) + 4 * n + (i & 3); }

struct Unit { int pm, pn; };
struct Gemm { const bf16_t* A; const bf16_t* Bt; int M, N, K; };

struct StaticOrder {
    int nM, nN, nwg, G, c;
    __host__ __device__ void init(int M, int N, int G_, int c_) { nM = M / BM; nN = N / BM; nwg = nM * nN; G = G_; c = c_; }
    __host__ __device__ bool next(int i, Unit& u) const {
        const long L = (long)i * G + c; if (L >= nwg) return false;
        int wgid = (int)L; { const int q = nwg / NXCD, r = nwg % NXCD, xcd = wgid % NXCD, off = wgid / NXCD; wgid = (xcd < r ? xcd * (q + 1) : r * (q + 1) + (xcd - r) * q) + off; }
        const int nig = WGM * nN, gid = wgid / nig, fm = gid * WGM, gsz = (nM - fm) < WGM ? (nM - fm) : WGM;
        u.pm = fm + ((wgid % nig) % gsz); u.pn = (wgid % nig) / gsz; return true;
    }
    __device__ __forceinline__ void a_ready(const Unit&) const {}
    __device__ __forceinline__ void done(const Unit&) const {}
};

__device__ __forceinline__ unsigned cvt_pk_bf16(float lo, float hi) { unsigned r; asm volatile("v_cvt_pk_bf16_f32 %0, %1, %2" : "=v"(r) : "v"(lo), "v"(hi)); return r; }
typedef float f32x2 __attribute__((ext_vector_type(2)));
__device__ __forceinline__ f32x2 gelu_pk(f32x2 v) {
    const f32x2 av = __builtin_elementwise_abs(v), d = av * 0.2316418882f + 1.0f;
    f32x2 t; t.x = __builtin_amdgcn_rcpf(d.x); t.y = __builtin_amdgcn_rcpf(d.y);
    f32x2 q = t * 0.5307027145f + (-0.7265760135f); q = q * t + 0.7107068705f; q = q * t + (-0.142248368f); q = q * t + 0.127414796f; q = q * t;
    const f32x2 s = (v * v) * (-0.72134752044f);
    f32x2 e; e.x = __builtin_amdgcn_exp2f(s.x); e.y = __builtin_amdgcn_exp2f(s.y);
    const f32x2 m = v * (q * e), r = v - m;
    f32x2 o; o.x = v.x < 0.f ? m.x : r.x; o.y = v.y < 0.f ? m.y : r.y; return o;
}

template <int ACT  > struct EpiBf16 {
    static constexpr bool PERM = true, AFTER_DRAIN = false; static_assert(ACT == 0 || ACT == 1, "EpiBf16: ACT is 0 (none) or 1 (gelu_pk)");
    bf16_t* O; int ldc; const float* bias; int split_cols; size_t split_stride; float scale0;
    __device__ __forceinline__ void operator()(const f32x4 (&acc)[2][2][4][2], const Unit& u, int wr, int wc, int fr, int fq) const {
        const int row0 = u.pm * BM + wr * 64 + fr; int colt = u.pn * BM; bf16_t* base = O;
        float sc = 1.f; if (split_cols) { const int t = colt / split_cols; base += (size_t)t * split_stride; colt -= t * split_cols; if (t == 0) sc = scale0; }
        const int col0 = colt + wc * 32 + 8 * fq, bcol0 = u.pn * BM + wc * 32 + 8 * fq;
        f32x4 bv[2][2];
#pragma unroll
        for (int bj = 0; bj < 2; ++bj)
#pragma unroll
            for (int n = 0; n < 2; ++n) bv[bj][n] = bias ? *(const f32x4*)(bias + bcol0 + bj * HALF + 4 * n) : (f32x4){0.f, 0.f, 0.f, 0.f};
#pragma unroll
        for (int ai = 0; ai < 2; ++ai)
#pragma unroll
            for (int m = 0; m < 4; ++m) { bf16_t* rowp = base + (size_t)(row0 + ai * HALF + m * 16) * ldc + col0;
#pragma unroll
                for (int bj = 0; bj < 2; ++bj) { f32x4 v0 = acc[ai][bj][m][0] + bv[bj][0], v1 = acc[ai][bj][m][1] + bv[bj][1];
                    if (ACT == 1) { f32x2 a = gelu_pk((f32x2){v0[0], v0[1]}), b = gelu_pk((f32x2){v0[2], v0[3]}), c = gelu_pk((f32x2){v1[0], v1[1]}), d = gelu_pk((f32x2){v1[2], v1[3]});
                        v0 = (f32x4){a.x, a.y, b.x, b.y}; v1 = (f32x4){c.x, c.y, d.x, d.y}; }
                    v0 = v0 * sc; v1 = v1 * sc; u32x4 w; w.x = cvt_pk_bf16(v0[0], v0[1]); w.y = cvt_pk_bf16(v0[2], v0[3]); w.z = cvt_pk_bf16(v1[0], v1[1]); w.w = cvt_pk_bf16(v1[2], v1[3]);
                    *(u32x4*)(rowp + bj * HALF) = w; } }
    }
};

template <class Epi, class Sched, bool ALIGN_EPI = false, bool SP2 = false>
__device__ __forceinline__ void gemm_phase(PG8_LAS unsigned char* lds, const Gemm g, const Sched& S, const Epi& E) {
    const int tid = threadIdx.x, wid = __builtin_amdgcn_readfirstlane(tid >> 6), lane = tid & 63, wr = wid >> 2, wc = wid & 3, fr = lane & 15, fq = lane >> 4;
    const int K = g.K, nt = K / BK;
    unsigned voffA[2], voffB[2];
#pragma unroll
    for (int i = 0; i < 2; ++i) { int R, C; stage_rc(tid * 16 + i * 8192, R, C); const int Rb = Epi::PERM ? ((R & ~31) + perm32(R & 31)) : R;
        voffA[i] = (unsigned)(R * K + C) * 2u; voffB[i] = (unsigned)(Rb * K + C) * 2u; }
    const size_t kstep = (size_t)(BK * 2);
    const size_t hstep = (size_t)HALF * K * 2;
    const size_t tstep = 2 * hstep;
    const unsigned ldsw = (unsigned)wid * 1024u;
    const int aoff = lds_byte(wr * 64 + fr, fq * 8), boff = lds_byte(wc * 32 + fr, fq * 8);
#define PG8_SA(b, h) (((b) * 2 + (h)) * HTB)
#define PG8_SB(b, h) ((4 + (b) * 2 + (h)) * HTB)
#define PG8_STAGE(bufoff, gbase, voff) do { _Pragma("unroll") for (int _i = 0; _i < 2; ++_i) \
        __builtin_amdgcn_global_load_lds((const unsigned*)((const char*)(gbase) + (voff)[_i]), (PG8_LAS unsigned*)(lds + (bufoff) + ldsw + _i * 8192), 16, 0, 0); } while (0)
#define PG8_LDA(dst, b, h) do { _Pragma("unroll") for (int m = 0; m < 4; ++m) _Pragma("unroll") for (int k = 0; k < 2; ++k) dst[m][k] = *(const PG8_LAS bf16x8*)(lds + PG8_SA(b, h) + aoff + m * 2048 + k * 1024); } while (0)
#define PG8_LDB(dst, b, h) do { _Pragma("unroll") for (int n = 0; n < 2; ++n) _Pragma("unroll") for (int k = 0; k < 2; ++k) dst[n][k] = *(const PG8_LAS bf16x8*)(lds + PG8_SB(b, h) + boff + n * 2048 + k * 1024); } while (0)
#define PG8_MMA(ai, bj, At, Bt) do { __builtin_amdgcn_s_setprio(1); _Pragma("unroll") for (int m = 0; m < 4; ++m) _Pragma("unroll") for (int n = 0; n < 2; ++n) _Pragma("unroll") for (int k = 0; k < 2; ++k) \
        acc[ai][bj][m][n] = __builtin_amdgcn_mfma_f32_16x16x32_bf16(Bt[n][k], At[m][k], acc[ai][bj][m][n], 0, 0, 0); __builtin_amdgcn_s_setprio(0); } while (0)
#define PG8_WAIT_V(n) asm volatile("s_waitcnt vmcnt(" #n ")" ::: "memory")
#define PG8_WAIT_L(n) asm volatile("s_waitcnt lgkmcnt(" #n ")" ::: "memory")
#define PG8_BAR __builtin_amdgcn_s_barrier()
#define PG8_SCHED __builtin_amdgcn_sched_barrier(0)
    Unit cur, nxt; int ui = 0;
    if (!S.next(0, cur)) return;
    f32x4 acc[2][2][4][2];
#pragma unroll
    for (int a = 0; a < 2; ++a)
#pragma unroll
        for (int b = 0; b < 2; ++b)
#pragma unroll
            for (int m = 0; m < 4; ++m)
#pragma unroll
                for (int n = 0; n < 2; ++n) acc[a][b][m][n] = (f32x4){0.f, 0.f, 0.f, 0.f};
    bf16x8 At[4][2], B0[2][2], B1[2][2];
    const char* cA = (const char*)g.A + (size_t)cur.pm * tstep; const char* cB = (const char*)g.Bt + (size_t)cur.pn * tstep;
    S.a_ready(cur);
    if constexpr (SP2) {
        PG8_STAGE(PG8_SB(0, 0), cB, voffB); PG8_STAGE(PG8_SB(0, 1), cB + hstep, voffB); PG8_STAGE(PG8_SA(0, 0), cA, voffA); PG8_STAGE(PG8_SA(0, 1), cA + hstep, voffA);
        if (wr == 1) PG8_BAR;
        PG8_WAIT_V(2); PG8_BAR;
        PG8_STAGE(PG8_SB(1, 0), cB + kstep, voffB); PG8_STAGE(PG8_SA(1, 0), cA + kstep, voffA); PG8_STAGE(PG8_SB(1, 1), cB + hstep + kstep, voffB);
        PG8_WAIT_V(6); PG8_BAR;
    } else {
        PG8_STAGE(PG8_SB(0, 0), cB, voffB); PG8_STAGE(PG8_SA(0, 0), cA, voffA); PG8_STAGE(PG8_SB(0, 1), cB + hstep, voffB); PG8_STAGE(PG8_SA(0, 1), cA + hstep, voffA);
        if (wr == 1) PG8_BAR;
        PG8_WAIT_V(4); PG8_BAR;
        PG8_STAGE(PG8_SB(1, 0), cB + kstep, voffB); PG8_STAGE(PG8_SA(1, 0), cA + kstep, voffA); PG8_STAGE(PG8_SB(1, 1), cB + hstep + kstep, voffB);
        PG8_WAIT_V(6); PG8_BAR;
    }
    for (;;) {
        const bool has_next = S.next(ui + 1, nxt);
        const char* nA = has_next ? (const char*)g.A + (size_t)nxt.pm * tstep : cA; const char* nB = has_next ? (const char*)g.Bt + (size_t)nxt.pn * tstep : cB;
        for (int t = 0; t < nt; t += 2) {
            const bool last = (t == nt - 2);
            const char* a1 = cA + (size_t)(t + 1) * kstep;
            const char* a2 = last ? nA : cA + (size_t)(t + 2) * kstep; const char* b2 = last ? nB : cB + (size_t)(t + 2) * kstep;
            const char* a3 = a2 + kstep; const char* b3 = b2 + kstep;
            if (last && has_next) S.a_ready(nxt);
            if constexpr (SP2) {
            PG8_LDB(B0, 0, 0); PG8_LDB(B1, 0, 1); PG8_SCHED; PG8_LDA(At, 0, 0); PG8_STAGE(PG8_SA(1, 1), a1 + hstep, voffA);
            PG8_WAIT_V(8); PG8_WAIT_L(0); PG8_BAR; PG8_MMA(0, 0, At, B0); PG8_MMA(0, 1, At, B1); PG8_BAR; PG8_SCHED;
            PG8_LDA(At, 0, 1); PG8_STAGE(PG8_SB(0, 0), b2, voffB); PG8_STAGE(PG8_SB(0, 1), b2 + hstep, voffB); PG8_STAGE(PG8_SA(0, 0), a2, voffA);
            PG8_WAIT_V(8); PG8_WAIT_L(0); PG8_BAR; PG8_MMA(1, 0, At, B0); PG8_MMA(1, 1, At, B1); PG8_BAR; PG8_SCHED;
            PG8_LDB(B0, 1, 0); PG8_LDB(B1, 1, 1); PG8_SCHED; PG8_LDA(At, 1, 0); PG8_STAGE(PG8_SA(0, 1), a2 + hstep, voffA);
            PG8_WAIT_V(8); PG8_WAIT_L(0); PG8_BAR; PG8_MMA(0, 0, At, B0); PG8_MMA(0, 1, At, B1); PG8_BAR; PG8_SCHED;
            PG8_LDA(At, 1, 1); PG8_STAGE(PG8_SB(1, 0), b3, voffB); PG8_STAGE(PG8_SB(1, 1), b3 + hstep, voffB); PG8_STAGE(PG8_SA(1, 0), a3, voffA);
            PG8_WAIT_V(8); PG8_WAIT_L(0); PG8_BAR; PG8_MMA(1, 0, At, B0); PG8_MMA(1, 1, At, B1); PG8_BAR; PG8_SCHED;
            } else {
            PG8_LDB(B0, 0, 0); PG8_SCHED; PG8_LDA(At, 0, 0); PG8_STAGE(PG8_SA(1, 1), a1 + hstep, voffA);
            PG8_WAIT_L(8); PG8_BAR; PG8_WAIT_L(0); PG8_MMA(0, 0, At, B0); PG8_BAR; PG8_SCHED;
            PG8_LDB(B1, 0, 1); PG8_STAGE(PG8_SB(0, 0), b2, voffB);
            PG8_BAR; PG8_WAIT_L(0); PG8_MMA(0, 1, At, B1); PG8_BAR;
            PG8_LDA(At, 0, 1); PG8_STAGE(PG8_SA(0, 0), a2, voffA);
            PG8_BAR; PG8_WAIT_L(0); PG8_MMA(1, 0, At, B0); PG8_BAR; PG8_SCHED;
            PG8_STAGE(PG8_SB(0, 1), b2 + hstep, voffB);
            PG8_WAIT_V(6); PG8_BAR; PG8_MMA(1, 1, At, B1); PG8_BAR;
            PG8_LDB(B0, 1, 0); PG8_SCHED; PG8_LDA(At, 1, 0); PG8_STAGE(PG8_SA(0, 1), a2 + hstep, voffA);
            PG8_WAIT_L(8); PG8_BAR; PG8_WAIT_L(0); PG8_MMA(0, 0, At, B0); PG8_BAR; PG8_SCHED;
            PG8_LDB(B1, 1, 1); PG8_STAGE(PG8_SB(1, 0), b3, voffB);
            PG8_BAR; PG8_WAIT_L(0); PG8_MMA(0, 1, At, B1); PG8_BAR;
            PG8_LDA(At, 1, 1); PG8_STAGE(PG8_SA(1, 0), a3, voffA);
            PG8_BAR; PG8_WAIT_L(0); PG8_MMA(1, 0, At, B0); PG8_BAR; PG8_SCHED;
            PG8_STAGE(PG8_SB(1, 1), b3 + hstep, voffB);
            PG8_WAIT_V(6); PG8_BAR; PG8_MMA(1, 1, At, B1); PG8_BAR;
            }
        }
        if constexpr (ALIGN_EPI) { if (wr == 0) PG8_BAR; }
        if constexpr (!Epi::AFTER_DRAIN) { E(acc, cur, wr, wc, fr, fq); S.done(cur); }
        if (!has_next) break;
#pragma unroll
        for (int a = 0; a < 2; ++a)
#pragma unroll
            for (int b = 0; b < 2; ++b)
#pragma unroll
                for (int m = 0; m < 4; ++m)
#pragma unroll
                    for (int n = 0; n < 2; ++n) acc[a][b][m][n] = (f32x4){0.f, 0.f, 0.f, 0.f};
        cur = nxt; cA = nA; cB = nB; ++ui;
        if constexpr (ALIGN_EPI) { if (wr == 1) PG8_BAR; }
    }
    PG8_WAIT_V(0);
    if constexpr (!ALIGN_EPI) { if (wr == 0) PG8_BAR; }
    PG8_BAR;
    if constexpr (Epi::AFTER_DRAIN) { E.fused(acc, cur, wr, wc, fr, fq, lds, wid, lane); S.done(cur); }
#undef PG8_SA
#undef PG8_SB
#undef PG8_STAGE
#undef PG8_LDA
#undef PG8_LDB
#undef PG8_MMA
#undef PG8_WAIT_V
#undef PG8_WAIT_L
#undef PG8_BAR
#undef PG8_SCHED
}
}
#define XB_TMO      128
#define XB_XCNT(j)  (256  + 64 * (j))
#define XB_XSUB(j)  (1280 + 64 * (j))
#define XB_XGEN(j)  (2304 + 64 * (j))
#define XB_TOP      3328
#define XB_TOPGEN   3392
#define XCD_BAR_WORDS 3456
#define XB_SPIN_CAP (1u << 18)

__device__ __forceinline__ unsigned xb_ld(unsigned* p)              { return __hip_atomic_load(p, __ATOMIC_RELAXED, __HIP_MEMORY_SCOPE_AGENT); }
__device__ __forceinline__ unsigned xb_add(unsigned* p, unsigned v) { return __hip_atomic_fetch_add(p, v, __ATOMIC_RELAXED, __HIP_MEMORY_SCOPE_AGENT); }
__device__ __forceinline__ unsigned xb_xcc_id() { return (unsigned)__builtin_amdgcn_s_getreg((3 << 11) | 20) & 0xFu; }
#define XB_SPIN(cond, bar) do { unsigned _sp = 0; while (cond) { __builtin_amdgcn_s_sleep(1); \
    if ((++_sp & 255u) == 0u) { if (xb_ld(&(bar)[XB_TMO])) break; if (_sp > XB_SPIN_CAP) { atomicAdd(&(bar)[XB_TMO], 1u); break; } } } } while (0)

struct XcdBarrier {
    unsigned* bar; unsigned x;
    volatile LAS unsigned* st;
};

__device__ __forceinline__ XcdBarrier xcd_barrier_post(unsigned* bar, volatile LAS unsigned* st) {
    XcdBarrier b; b.bar = bar; b.x = xb_xcc_id(); b.st = st;
    if (threadIdx.x == 0) (void)xb_add(&bar[XB_XCNT(b.x)], 1u);
    return b;
}
__device__ __forceinline__ void xcd_barrier_complete(unsigned* bar, unsigned x, unsigned& nloc, unsigned& nx) {
    const unsigned G = gridDim.x * gridDim.y * gridDim.z;
    unsigned sum, cnt, mine, sp = 0u;
    for (;;) {
        sum = 0u; cnt = 0u; mine = 0u;
#pragma unroll
        for (unsigned j = 0; j < 16; ++j) { const unsigned c = xb_ld(&bar[XB_XCNT(j)]); sum += c; cnt += (c > 0u) ? 1u : 0u; mine = (j == x) ? c : mine; }
        if (sum == G) break;
        __builtin_amdgcn_s_sleep(1);
        if ((++sp & 255u) == 0u) { if (xb_ld(&bar[XB_TMO])) break; if (sp > XB_SPIN_CAP) { atomicAdd(&bar[XB_TMO], 1u); break; } }
    }
    nloc = mine > 0u ? mine : 1u; nx = cnt > 0u ? cnt : 1u;
}

__device__ __forceinline__ void xcd_barrier(const XcdBarrier& b) {
    asm volatile("s_waitcnt vmcnt(0)" ::: "memory");
    __syncthreads();
    if (threadIdx.x == 0) {
        unsigned* bar = b.bar;
        __builtin_amdgcn_s_waitcnt(0);
        unsigned nloc = b.st[0], nx = b.st[1];
        if (nloc == 0u) { xcd_barrier_complete(bar, b.x, nloc, nx); b.st[0] = nloc; b.st[1] = nx; }
        const unsigned old = xb_add(&bar[XB_XSUB(b.x)], 1u);
        const unsigned gen = old / nloc;
        if (old + 1u == (gen + 1u) * nloc) {
            __builtin_amdgcn_fence(__ATOMIC_RELEASE, "agent");
            asm volatile("s_waitcnt vmcnt(0)" ::: "memory");
            const unsigned og = xb_add(&bar[XB_TOP], 1u);
            const unsigned tg = og / nx;
            if (og + 1u == (tg + 1u) * nx) xb_add(&bar[XB_TOPGEN], 1u);
            else XB_SPIN(xb_ld(&bar[XB_TOPGEN]) == tg, bar);
            __builtin_amdgcn_fence(__ATOMIC_ACQUIRE, "agent");
            xb_add(&bar[XB_XGEN(b.x)], 1u);
            asm volatile("s_waitcnt vmcnt(0)" ::: "memory");
        } else {
            XB_SPIN(xb_ld(&bar[XB_XGEN(b.x)]) == gen, bar);
            __builtin_amdgcn_fence(__ATOMIC_ACQUIRE, "agent");
            asm volatile("s_waitcnt vmcnt(0)" ::: "memory");
        }
    }
    __syncthreads();
}

constexpr int NWAVES = 8, NTHR = 512;
constexpr int DM = 2048, MP = 8192, MS = 1024, MT = MP + MS;
constexpr int DFF = 5632, DIN = 6144, NH = 8, HE = 128, HV = 128, CC = 1024, CW = 31, MEML = 256, XH = 4, XD = 128, XDIM = 512;
constexpr float EPS = 1e-6f;
constexpr size_t O_Y = 0, O_SHP = 18874368, O_SCP = 19398656, O_MKP = 19521536, O_MVP = 20045824, O_SHS = 20570112, O_SCS = 37347328, O_END = 41279488;
constexpr size_t MiB = 1u << 20;
constexpr size_t WS_CTL = 0, CTL_ZERO_BYTES = 1 * MiB;
constexpr size_t WS_WGU1 = 2 * MiB, WS_WD1 = 46 * MiB, WS_WIN = 68 * MiB, WS_WOUT = 92 * MiB, WS_WQ = 100 * MiB, WS_WKV = 102 * MiB, WS_WO = 106 * MiB, WS_WGU2 = 108 * MiB, WS_WD2 = 152 * MiB;
constexpr size_t WS_XA = 174 * MiB, WS_MN = 210 * MiB, WS_X = 214 * MiB, WS_H = 286 * MiB;
constexpr size_t WS_QH = WS_H, WS_VH = WS_H + 18 * MiB, WS_GH = WS_H + 36 * MiB, WS_LOGF = WS_H + 54 * MiB;
constexpr size_t WS_U = 385 * MiB, WS_OB = 421 * MiB, WS_DS = 457 * MiB, WS_SST = 521 * MiB, WS_DEC = 553 * MiB, WS_KB = 554 * MiB, WS_VB = 555 * MiB, WS_QB = 556 * MiB, WS_AO = 565 * MiB, WS_END = 574 * MiB;
constexpr int CW_BAR = 4096;
constexpr int RING_OFF = 0, LDS_BYTES = 147456, MISC_OFF = LDS_BYTES - 256;

typedef unsigned u32x2 __attribute__((ext_vector_type(2)));
__device__ __forceinline__ float bf2f(unsigned short h) { return __builtin_bit_cast(float, (unsigned)h << 16); }
__device__ __forceinline__ float fexp(float x) { return __builtin_amdgcn_exp2f(x * 1.4426950408889634f); }
__device__ __forceinline__ float fsigmoid(float x) { return __builtin_amdgcn_rcpf(1.f + fexp(-x)); }
__device__ __forceinline__ float fsilu(float x) { return x * fsigmoid(x); }
__device__ __forceinline__ float wave_sum(float v) {
#pragma unroll
    for (int o = 1; o < 64; o <<= 1) v += __shfl_xor(v, o);
    return v;
}
using pg8::cvt_pk_bf16;

struct EpiSwiGLU {
    static constexpr bool PERM = true, AFTER_DRAIN = false;
    bf16* H; int ldh;
    __device__ __forceinline__ void operator()(const f32x4 (&acc)[2][2][4][2], const pg8::Unit& u, int wr, int wc, int fr, int fq) const {
        const int row0 = u.pm * 256 + wr * 64 + fr, col0 = u.pn * 128 + wc * 32 + 8 * fq;
#pragma unroll
        for (int ai = 0; ai < 2; ++ai)
#pragma unroll
            for (int m = 0; m < 4; ++m) {
                bf16* rowp = H + (size_t)(row0 + ai * 128 + m * 16) * ldh + col0;
                const f32x4 g0 = acc[ai][0][m][0], g1 = acc[ai][0][m][1], u0 = acc[ai][1][m][0], u1 = acc[ai][1][m][1];
                v4u w;
                w.x = cvt_pk_bf16(fsilu(g0[0]) * u0[0], fsilu(g0[1]) * u0[1]); w.y = cvt_pk_bf16(fsilu(g0[2]) * u0[2], fsilu(g0[3]) * u0[3]);
                w.z = cvt_pk_bf16(fsilu(g1[0]) * u1[0], fsilu(g1[1]) * u1[1]); w.w = cvt_pk_bf16(fsilu(g1[2]) * u1[2], fsilu(g1[3]) * u1[3]);
                *(v4u*)rowp = w;
            }
    }
};
struct EpiResid {
    static constexpr bool PERM = false, AFTER_DRAIN = false;
    float* X; int ldc; float scale;
    __device__ __forceinline__ void operator()(const f32x4 (&acc)[2][2][4][2], const pg8::Unit& u, int wr, int wc, int fr, int fq) const {
        const int row0 = u.pm * 256 + wr * 64 + fr, col0 = u.pn * 256 + wc * 32 + 4 * fq;
#pragma unroll
        for (int ai = 0; ai < 2; ++ai)
#pragma unroll
            for (int m = 0; m < 4; ++m) {
                float* rowp = X + (size_t)(row0 + ai * 128 + m * 16) * ldc + col0;
#pragma unroll
                for (int bj = 0; bj < 2; ++bj)
#pragma unroll
                    for (int n = 0; n < 2; ++n) { f32x4* p = (f32x4*)(rowp + bj * 128 + n * 16); *p = *p + acc[ai][bj][m][n] * scale; }
            }
    }
};
struct EpiKV {
    static constexpr bool PERM = false, AFTER_DRAIN = false;
    float* outK; float* outV; bf16* KB; bf16* VB;
    __device__ __forceinline__ void operator()(const f32x4 (&acc)[2][2][4][2], const pg8::Unit& u, int wr, int wc, int fr, int fq) const {
        const int row0 = u.pm * 256 + wr * 64 + fr; const bool isv = u.pn >= 2; const int col0 = (u.pn & 1) * 256 + wc * 32 + 4 * fq;
        float* of = isv ? outV : outK; bf16* ob = isv ? VB : KB;
#pragma unroll
        for (int ai = 0; ai < 2; ++ai)
#pragma unroll
            for (int m = 0; m < 4; ++m) {
                const size_t ro = (size_t)(row0 + ai * 128 + m * 16) * XDIM + col0;
#pragma unroll
                for (int bj = 0; bj < 2; ++bj)
#pragma unroll
                    for (int n = 0; n < 2; ++n) { const f32x4 v = acc[ai][bj][m][n]; *(f32x4*)(of + ro + bj * 128 + n * 16) = v;
                        u32x2 w; w.x = cvt_pk_bf16(v[0], v[1]); w.y = cvt_pk_bf16(v[2], v[3]); *(u32x2*)(ob + ro + bj * 128 + n * 16) = w; }
            }
    }
};
struct EpiWin {
    static constexpr bool PERM = true, AFTER_DRAIN = false;
    bf16* QH; bf16* VH; bf16* GH; float* LOGF; float* U; const float* lbp;
    __device__ __forceinline__ void operator()(const f32x4 (&acc)[2][2][4][2], const pg8::Unit& u, int wr, int wc, int fr, int fq) const {
        const int row0 = u.pm * 256 + wr * 64 + fr; const int ty = u.pn >> 2;
        if (ty == 0 || ty == 2 || ty == 3) {
            bf16* dst = QH + (size_t)(ty == 0 ? 0 : ty - 1) * (size_t)(9u << 20); const int col0 = (u.pn & 3) * 256 + wc * 32 + 8 * fq;
#pragma unroll
            for (int ai = 0; ai < 2; ++ai)
#pragma unroll
                for (int m = 0; m < 4; ++m) { bf16* rowp = dst + (size_t)(row0 + ai * 128 + m * 16) * 1024 + col0;
#pragma unroll
                    for (int bj = 0; bj < 2; ++bj) { f32x4 v0 = acc[ai][bj][m][0], v1 = acc[ai][bj][m][1];
                        if (ty != 2) {
#pragma unroll
                            for (int i = 0; i < 4; ++i) { v0[i] = fsilu(v0[i]); v1[i] = fsilu(v1[i]); } }
                        v4u w; w.x = cvt_pk_bf16(v0[0], v0[1]); w.y = cvt_pk_bf16(v0[2], v0[3]); w.z = cvt_pk_bf16(v1[0], v1[1]); w.w = cvt_pk_bf16(v1[2], v1[3]);
                        *(v4u*)(rowp + bj * 128) = w; } }
        } else if (ty == 1) {
            const int col0 = (u.pn & 3) * 256 + wc * 32 + 8 * fq;
            f32x4 lb[2][2];
#pragma unroll
            for (int bj = 0; bj < 2; ++bj)
#pragma unroll
                for (int n = 0; n < 2; ++n) { const f32x4 a0 = *(const f32x4*)(lbp + col0 + bj * 128 + 4 * n), a1 = *(const f32x4*)(lbp + 1024 + col0 + bj * 128 + 4 * n);
#pragma unroll
                    for (int i = 0; i < 4; ++i) lb[bj][n][i] = fsigmoid(a0[i] - a1[i]); }
#pragma unroll
            for (int ai = 0; ai < 2; ++ai)
#pragma unroll
                for (int m = 0; m < 4; ++m) { float* rowp = LOGF + (size_t)(row0 + ai * 128 + m * 16) * 1024 + col0;
#pragma unroll
                    for (int bj = 0; bj < 2; ++bj)
#pragma unroll
                        for (int n = 0; n < 2; ++n) { const f32x4 z = acc[ai][bj][m][n]; f32x4 o;
#pragma unroll
                            for (int i = 0; i < 4; ++i) { const float l = lb[bj][n][i]; o[i] = __logf(l + (1.f - l) * fsigmoid(z[i])); }
                            *(f32x4*)(rowp + bj * 128 + 4 * n) = o; } }
        } else {
            const int col0 = (u.pn - 16) * 128 + wc * 32 + 8 * fq;
#pragma unroll
            for (int ai = 0; ai < 2; ++ai)
#pragma unroll
                for (int m = 0; m < 4; ++m) { float* rowp = U + (size_t)(row0 + ai * 128 + m * 16) * 1024 + col0;
#pragma unroll
                    for (int n = 0; n < 2; ++n) { const f32x4 a = acc[ai][0][m][n], b = acc[ai][1][m][n]; f32x4 o;
#pragma unroll
                        for (int i = 0; i < 4; ++i) o[i] = a[i] * fsigmoid(b[i]);
                        *(f32x4*)(rowp + 4 * n) = o; } }
        }
    }
};

__device__ __forceinline__ void p0_transpose_item(const float* W, int K, int N, bf16* WT, int dst_row0, LAS float* scr, int k0, int n0, int lane) {
#pragma unroll 8
    for (int i = 0; i < 32; ++i) { const int kk = 2 * i + (lane >> 5); scr[kk * 33 + (lane & 31)] = W[(size_t)(k0 + kk) * N + n0 + (lane & 31)]; }
    LDS_WAIT(); asm volatile("" ::: "memory");
    const int c = lane & 7;
#pragma unroll
    for (int j = 0; j < 4; ++j) { const int n = (lane >> 3) + 8 * j; const LAS float* s = scr + (8 * c) * 33 + n;
        v4u o; o.x = pk2(s[0 * 33], s[1 * 33]); o.y = pk2(s[2 * 33], s[3 * 33]); o.z = pk2(s[4 * 33], s[5 * 33]); o.w = pk2(s[6 * 33], s[7 * 33]);
        *(v4u*)(WT + (size_t)(dst_row0 + n) * K + k0 + 8 * c) = o; }
    LDS_WAIT(); asm volatile("" ::: "memory");
}
__device__ __forceinline__ int map_pair(int n0, int second) { return 256 * (n0 >> 7) + 128 * second + (n0 & 127); }
__device__ __forceinline__ void rms_row_bf16(const float* xrow, const float* g, bf16* orow, float* copy, int lane) {
    const f32x4* xr = (const f32x4*)xrow + lane; f32x4 v[8]; float s = 0.f;
#pragma unroll
    for (int j = 0; j < 8; ++j) { v[j] = xr[64 * j]; s += (v[j][0] * v[j][0] + v[j][1] * v[j][1]) + (v[j][2] * v[j][2] + v[j][3] * v[j][3]); }
    if (copy) {
#pragma unroll
        for (int j = 0; j < 8; ++j) ((f32x4*)copy + lane)[64 * j] = v[j]; }
    const float r = 1.f / sqrtf(wave_sum(s) * (1.f / DM) + EPS);
    u32x2* o8 = (u32x2*)orow + lane;
#pragma unroll
    for (int j = 0; j < 8; ++j) { const f32x4 gg = ((const f32x4*)g + lane)[64 * j]; u32x2 w; w.x = cvt_pk_bf16(v[j][0] * r * gg[0], v[j][1] * r * gg[1]); w.y = cvt_pk_bf16(v[j][2] * r * gg[2], v[j][3] * r * gg[3]); o8[64 * j] = w; }
}
__device__ __forceinline__ void rms_row_f32(const float* xrow, const float* g, float* orow, int lane) {
    const f32x4* xr = (const f32x4*)xrow + lane; f32x4 v[8]; float s = 0.f;
#pragma unroll
    for (int j = 0; j < 8; ++j) { v[j] = xr[64 * j]; s += (v[j][0] * v[j][0] + v[j][1] * v[j][1]) + (v[j][2] * v[j][2] + v[j][3] * v[j][3]); }
    const float r = 1.f / sqrtf(wave_sum(s) * (1.f / DM) + EPS);
#pragma unroll
    for (int j = 0; j < 8; ++j) { const f32x4 gg = ((const f32x4*)g + lane)[64 * j]; ((f32x4*)orow + lane)[64 * j] = v[j] * r * gg; }
}

struct Args { const float* in[31]; float* out; unsigned char* ws; int ph_lo, ph_hi, li, pad; };

#define BSYNC() __syncthreads()

__device__ __forceinline__ void hg_cumsum64(LAS float* Lb, int tid) {
    const int e = tid & 127, part = tid >> 7;
    { float a = 0.f;
#pragma unroll
      for (int i = 0; i < 16; ++i) { a += Lb[(16 * part + i) * 128 + e]; Lb[(16 * part + i) * 128 + e] = a; } }
    BSYNC();
    float off = 0.f;
#pragma unroll
    for (int p = 0; p < 3; ++p) if (p < part) off += Lb[(16 * p + 15) * 128 + e];
    BSYNC();
#pragma unroll
    for (int i = 0; i < 16; ++i) Lb[(16 * part + i) * 128 + e] += off;
    BSYNC();
}
__device__ __forceinline__ void hg_load_vt(const bf16* VH, int r0, int h, LAS bf16* VT, int tid) {
    const int s = tid >> 3, ch = tid & 7; const bf16* src = VH + (size_t)(r0 + s) * 1024 + h * 128 + 16 * ch;
    const v4u a = *(const v4u*)src, b = *(const v4u*)(src + 8);
    const unsigned w[8] = {a.x, a.y, a.z, a.w, b.x, b.y, b.z, b.w};
#pragma unroll
    for (int i = 0; i < 8; ++i) { VT[(16 * ch + 2 * i) * 72 + s] = (bf16)(w[i] & 0xffffu); VT[(16 * ch + 2 * i + 1) * 72 + s] = (bf16)(w[i] >> 16); }
}

__device__ __forceinline__ void hgrn_chunk_state(LAS unsigned char* lds, const float* LOGF, const bf16* VH, float* DS, float* DEC, int task, int tid) {
    LAS float* Lb = (LAS float*)lds; LAS float* Kk = (LAS float*)(lds + 32768); LAS bf16* KdT = (LAS bf16*)(lds + 65536); LAS bf16* VT = (LAS bf16*)(lds + 83968);
    const int n = task >> 8, h = (task >> 5) & 7, c = task & 31, r0 = n * 2048 + c * 64;
    const int lane = tid & 63, w = tid >> 6, fr = lane & 15, fq = lane >> 4;
#pragma unroll
    for (int i = 0; i < 4; ++i) { const int idx = tid + 512 * i, s = idx >> 5, e4 = idx & 31; const f32x4 v = *(const f32x4*)(LOGF + (size_t)(r0 + s) * 1024 + h * 128 + 4 * e4);
        *(LAS f32x4*)(Lb + s * 128 + 4 * e4) = v; f32x4 k; k[0] = 1.f - fexp(v[0]); k[1] = 1.f - fexp(v[1]); k[2] = 1.f - fexp(v[2]); k[3] = 1.f - fexp(v[3]); *(LAS f32x4*)(Kk + s * 128 + 4 * e4) = k; }
    hg_load_vt(VH, r0, h, VT, tid);
    BSYNC();
    hg_cumsum64(Lb, tid);
    { const int e = tid & 127, part = tid >> 7; const float bend = Lb[63 * 128 + e]; float kd[16];
#pragma unroll
      for (int i = 0; i < 16; ++i) { const int s = 16 * part + i; kd[i] = Kk[s * 128 + e] * fexp(bend - Lb[s * 128 + e]); }
      v4u o0, o1; o0.x = cvt_pk_bf16(kd[0], kd[1]); o0.y = cvt_pk_bf16(kd[2], kd[3]); o0.z = cvt_pk_bf16(kd[4], kd[5]); o0.w = cvt_pk_bf16(kd[6], kd[7]);
      o1.x = cvt_pk_bf16(kd[8], kd[9]); o1.y = cvt_pk_bf16(kd[10], kd[11]); o1.z = cvt_pk_bf16(kd[12], kd[13]); o1.w = cvt_pk_bf16(kd[14], kd[15]);
      *(LAS v4u*)(KdT + e * 72 + 16 * part) = o0; *(LAS v4u*)(KdT + e * 72 + 16 * part + 8) = o1;
      if (part == 0) DEC[(size_t)task * 128 + e] = fexp(bend); }
    BSYNC();
    f32x4 acc[8];
#pragma unroll
    for (int et = 0; et < 8; ++et) acc[et] = (f32x4){0.f, 0.f, 0.f, 0.f};
#pragma unroll
    for (int ks = 0; ks < 2; ++ks) { const bf16x8 a = *(const LAS bf16x8*)(VT + (16 * w + fr) * 72 + 32 * ks + 8 * fq);
#pragma unroll
        for (int et = 0; et < 8; ++et) { const bf16x8 b = *(const LAS bf16x8*)(KdT + (16 * et + fr) * 72 + 32 * ks + 8 * fq); acc[et] = __builtin_amdgcn_mfma_f32_16x16x32_bf16(a, b, acc[et], 0, 0, 0); } }
    float* dst = DS + (size_t)task * 16384;
#pragma unroll
    for (int et = 0; et < 8; ++et)
#pragma unroll
        for (int r = 0; r < 4; ++r) dst[(16 * w + 4 * fq + r) * 128 + 16 * et + fr] = acc[et][r];
    BSYNC();
}

__device__ __forceinline__ void hgrn_chunk_out(LAS unsigned char* lds, const float* LOGF, const bf16* QH, const bf16* VH, const bf16* GH, const bf16* SST, const float* gnorm, bf16* OB, int task, int tid) {
    LAS float* Lb = (LAS float*)lds; LAS bf16* SsT = (LAS bf16*)lds; LAS bf16* Qb = (LAS bf16*)(lds + 34816); LAS bf16* Qp = (LAS bf16*)(lds + 52224);
    LAS bf16* Kt = (LAS bf16*)(lds + 69632); LAS bf16* VT = (LAS bf16*)(lds + 113152); LAS bf16* Ab = (LAS bf16*)(lds + 131584); LAS float* red = (LAS float*)(lds + 140800);
    const int n = task >> 8, h = (task >> 5) & 7, c = task & 31, r0 = n * 2048 + c * 64;
    const int lane = tid & 63, w = tid >> 6, fr = lane & 15, fq = lane >> 4;
#pragma unroll
    for (int i = 0; i < 4; ++i) { const int idx = tid + 512 * i, s = idx >> 5, e4 = idx & 31; *(LAS f32x4*)(Lb + s * 128 + 4 * e4) = *(const f32x4*)(LOGF + (size_t)(r0 + s) * 1024 + h * 128 + 4 * e4); }
    hg_load_vt(VH, r0, h, VT, tid);
    for (int i = tid; i < 64 * 72 / 2; i += NTHR) ((LAS unsigned*)Ab)[i] = 0u;
    BSYNC();
    hg_cumsum64(Lb, tid);
    { const int e = tid & 127, part = tid >> 7;
      float rho[4]; rho[0] = 0.f; rho[1] = Lb[15 * 128 + e]; rho[2] = Lb[31 * 128 + e]; rho[3] = Lb[47 * 128 + e];
      const float rmine = part == 0 ? rho[0] : (part == 1 ? rho[1] : (part == 2 ? rho[2] : rho[3]));
#pragma unroll
      for (int i = 0; i < 16; ++i) { const int t = 16 * part + i; const float b = Lb[t * 128 + e]; const float bprev = t > 0 ? Lb[(t - 1) * 128 + e] : 0.f;
          const float k = 1.f - fexp(b - bprev); const float q = bf2f(QH[(size_t)(r0 + t) * 1024 + h * 128 + e]);
          Qb[t * 136 + e] = (bf16)f2bf(q * fexp(b)); Qp[t * 136 + e] = (bf16)f2bf(q * fexp(b - rmine));
#pragma unroll
          for (int ip = 0; ip < 4; ++ip) if (ip >= part) Kt[(8 * ip * (ip + 1) + t) * 136 + e] = (bf16)f2bf(k * fexp(rho[ip] - b)); } }
    BSYNC();
#pragma unroll
    for (int i = 0; i < 4; ++i) { const int idx = tid + 512 * i, d = idx >> 4, ch = idx & 15; *(LAS v4u*)(SsT + d * 136 + 8 * ch) = *(const v4u*)(SST + (size_t)task * 16384 + d * 128 + 8 * ch); }
    for (int tl = w; tl < 10; tl += 8) { const int i = tl < 1 ? 0 : (tl < 3 ? 1 : (tl < 6 ? 2 : 3)), j = tl - (i * (i + 1)) / 2;
        f32x4 a4 = (f32x4){0.f, 0.f, 0.f, 0.f};
#pragma unroll
        for (int ks = 0; ks < 4; ++ks) { const bf16x8 a = *(const LAS bf16x8*)(Qp + (16 * i + fr) * 136 + 32 * ks + 8 * fq); const bf16x8 b = *(const LAS bf16x8*)(Kt + (8 * i * (i + 1) + 16 * j + fr) * 136 + 32 * ks + 8 * fq);
            a4 = __builtin_amdgcn_mfma_f32_16x16x32_bf16(a, b, a4, 0, 0, 0); }
#pragma unroll
        for (int r = 0; r < 4; ++r) { float v = a4[r]; if (i == j && fr > 4 * fq + r) v = 0.f; Ab[(16 * i + 4 * fq + r) * 72 + 16 * j + fr] = (bf16)f2bf(v); } }
    BSYNC();
    const int tt = w & 3, dh = w >> 2;
    f32x4 acc[4];
#pragma unroll
    for (int k = 0; k < 4; ++k) acc[k] = (f32x4){0.f, 0.f, 0.f, 0.f};
#pragma unroll
    for (int ks = 0; ks < 2; ++ks) { const bf16x8 a = *(const LAS bf16x8*)(Ab + (16 * tt + fr) * 72 + 32 * ks + 8 * fq);
#pragma unroll
        for (int k = 0; k < 4; ++k) { const bf16x8 b = *(const LAS bf16x8*)(VT + (16 * (4 * dh + k) + fr) * 72 + 32 * ks + 8 * fq); acc[k] = __builtin_amdgcn_mfma_f32_16x16x32_bf16(a, b, acc[k], 0, 0, 0); } }
#pragma unroll
    for (int ks = 0; ks < 4; ++ks) { const bf16x8 a = *(const LAS bf16x8*)(Qb + (16 * tt + fr) * 136 + 32 * ks + 8 * fq);
#pragma unroll
        for (int k = 0; k < 4; ++k) { const bf16x8 b = *(const LAS bf16x8*)(SsT + (16 * (4 * dh + k) + fr) * 136 + 32 * ks + 8 * fq); acc[k] = __builtin_amdgcn_mfma_f32_16x16x32_bf16(a, b, acc[k], 0, 0, 0); } }
#pragma unroll
    for (int r = 0; r < 4; ++r) { float ss = 0.f;
#pragma unroll
        for (int k = 0; k < 4; ++k) ss += acc[k][r] * acc[k][r];
        ss += __shfl_xor(ss, 1); ss += __shfl_xor(ss, 2); ss += __shfl_xor(ss, 4); ss += __shfl_xor(ss, 8);
        if (fr == 0) red[(16 * tt + 4 * fq + r) * 2 + dh] = ss; }
    BSYNC();
#pragma unroll
    for (int r = 0; r < 4; ++r) { const int t = 16 * tt + 4 * fq + r; const float rs = 1.f / sqrtf((red[t * 2] + red[t * 2 + 1]) * (1.f / 128.f) + EPS); const size_t row = (size_t)(r0 + t);
#pragma unroll
        for (int k = 0; k < 4; ++k) { const int d = 16 * (4 * dh + k) + fr; const float v = acc[k][r] * rs * gnorm[d] * bf2f(GH[row * 1024 + h * 128 + d]); OB[row * 2048 + h * 128 + d] = (bf16)f2bf(v); } }
    BSYNC();
}

__device__ __forceinline__ void hgrn_sample(LAS unsigned char* lds, const float* LOGF, const bf16* QH, const bf16* VH, const bf16* GH, const float* S0g, float* Sout, const float* gnorm, bf16* OB, int task, int tid) {
    LAS float* bb = (LAS float*)lds; LAS float* qb = (LAS float*)(lds + 4096); LAS float* kd = (LAS float*)(lds + 8192); LAS float* vv = (LAS float*)(lds + 12288);
    LAS float* dec = (LAS float*)(lds + 16384); LAS float* Am = (LAS float*)(lds + 16896); LAS float* qraw = (LAS float*)(lds + 17408); LAS float* kraw = (LAS float*)(lds + 21504);
    LAS float* red = (LAS float*)(lds + 32768);
    const int n = task >> 3, h = task & 7, r0 = MP + n * 8;
#pragma unroll
    for (int i = 0; i < 2; ++i) { const int idx = tid + 512 * i, t = idx >> 7, e = idx & 127; const size_t g = (size_t)(r0 + t) * 1024 + h * 128 + e;
        const float lf = LOGF[g]; bb[idx] = lf; kraw[idx] = 1.f - fexp(lf); qraw[idx] = bf2f(QH[g]); vv[idx] = bf2f(VH[g]); }
    BSYNC();
    if (tid < 128) { const int e = tid; float a = 0.f; float bl[8];
#pragma unroll
        for (int t = 0; t < 8; ++t) { a += bb[t * 128 + e]; bl[t] = a; bb[t * 128 + e] = a; }
        dec[e] = fexp(a);
#pragma unroll
        for (int t = 0; t < 8; ++t) { qb[t * 128 + e] = qraw[t * 128 + e] * fexp(bl[t]); kd[t * 128 + e] = kraw[t * 128 + e] * fexp(a - bl[t]); } }
    BSYNC();
    { const int pair = tid >> 3, t = pair >> 3, s = pair & 7, es = tid & 7; float sum = 0.f;
      if (s <= t) {
#pragma unroll
          for (int i = 0; i < 16; ++i) { const int e = 16 * es + i; sum += qraw[t * 128 + e] * kraw[s * 128 + e] * fexp(bb[t * 128 + e] - bb[s * 128 + e]); } }
      sum += __shfl_xor(sum, 1); sum += __shfl_xor(sum, 2); sum += __shfl_xor(sum, 4);
      if (es == 0) Am[t * 8 + s] = sum; }
    { const int dq = tid & 31, eg = tid >> 5; f32x4 v4[8], po[8];
#pragma unroll
      for (int s = 0; s < 8; ++s) { v4[s] = *(const LAS f32x4*)(vv + s * 128 + 4 * dq); po[s] = (f32x4){0.f, 0.f, 0.f, 0.f}; }
      const float* sp = S0g + ((size_t)task * 128 + 8 * eg) * 128 + 4 * dq; float* op = Sout + ((size_t)task * 128 + 8 * eg) * 128 + 4 * dq;
      f32x4 s0[8];
#pragma unroll
      for (int k = 0; k < 8; ++k) s0[k] = *(const f32x4*)(sp + k * 128);
#pragma unroll
      for (int k = 0; k < 8; ++k) { const int e = 8 * eg + k; f32x4 sn = s0[k] * dec[e];
#pragma unroll
          for (int t = 0; t < 8; ++t) { po[t] += s0[k] * qb[t * 128 + e]; sn += v4[t] * kd[t * 128 + e]; }
          *(f32x4*)(op + k * 128) = sn; }
#pragma unroll
      for (int t = 0; t < 8; ++t) *(LAS f32x4*)(red + (eg * 8 + t) * 128 + 4 * dq) = po[t]; }
    BSYNC();
    { const int t = tid >> 6, dp = tid & 63; float o0 = 0.f, o1 = 0.f;
#pragma unroll
      for (int eg = 0; eg < 16; ++eg) { o0 += red[(eg * 8 + t) * 128 + 2 * dp]; o1 += red[(eg * 8 + t) * 128 + 2 * dp + 1]; }
#pragma unroll
      for (int s = 0; s < 8; ++s) { const float a = Am[t * 8 + s]; o0 += a * vv[s * 128 + 2 * dp]; o1 += a * vv[s * 128 + 2 * dp + 1]; }
      const float rs = 1.f / sqrtf(wave_sum(o0 * o0 + o1 * o1) * (1.f / 128.f) + EPS); const size_t row = (size_t)(r0 + t); const int d = 2 * dp;
      const unsigned gg = *(const unsigned*)(GH + row * 1024 + h * 128 + d);
      *(unsigned*)(OB + row * 2048 + h * 128 + d) = cvt_pk_bf16(o0 * rs * gnorm[d] * bf2f((bf16)(gg & 0xffffu)), o1 * rs * gnorm[d + 1] * bf2f((bf16)(gg >> 16))); }
    BSYNC();
}

__device__ __forceinline__ void conv_task(LAS unsigned char* lds, const float* U, const float* sconv, const float* cw, const float* cb, const float* lg, const float* lbeta, bf16* OB, int task, int tid) {
    LAS float* red = (LAS float*)lds;
    LAS float* tot = (LAS float*)(lds + 1024);
    const bool sample = task >= 1024; const int n = sample ? task - 1024 : task >> 8, t0 = sample ? 0 : (task & 255) * 8;
    const int urow0 = sample ? MP + n * 8 : n * 2048 + t0; const int c0 = 2 * tid, lane = tid & 63, w = tid >> 6;
    typedef float f32x2 __attribute__((ext_vector_type(2)));
    f32x2 wj[31];
#pragma unroll
    for (int j = 0; j < 31; ++j) wj[j] = *(const f32x2*)(cw + j * 1024 + c0);
    const f32x2 bias = *(const f32x2*)(cb + c0);
    f32x2 acc[8];
#pragma unroll
    for (int k = 0; k < 8; ++k) acc[k] = bias;
#pragma unroll
    for (int r = 0; r < 38; ++r) {
        f32x2 v = (f32x2){0.f, 0.f};
        if (sample && r < 30) v = *(const f32x2*)(sconv + ((size_t)n * 30 + r) * 1024 + c0);
        else if (sample || t0 + r - 30 >= 0) v = *(const f32x2*)(U + (size_t)(urow0 + r - 30) * 1024 + c0);
#pragma unroll
        for (int k = 0; k < 8; ++k) { const int j = r - k; if (j >= 0 && j <= 30) acc[k] += wj[j] * v; }
    }
#pragma unroll
    for (int k = 0; k < 8; ++k) { const float s1 = wave_sum(acc[k][0] + acc[k][1]), s2 = wave_sum(acc[k][0] * acc[k][0] + acc[k][1] * acc[k][1]); if (lane == 0) { red[w * 16 + 2 * k] = s1; red[w * 16 + 2 * k + 1] = s2; } }
    BSYNC();
    if (tid < 16) { float s = 0.f;
#pragma unroll
        for (int ww = 0; ww < 8; ++ww) s += red[ww * 16 + tid];
        tot[tid] = s; }
    BSYNC();
    const f32x2 g2 = *(const f32x2*)(lg + c0), b2 = *(const f32x2*)(lbeta + c0);
#pragma unroll
    for (int k = 0; k < 8; ++k) { const float mu = tot[2 * k] * (1.f / 1024.f); const float var = tot[2 * k + 1] * (1.f / 1024.f) - mu * mu; const float rstd = 1.f / sqrtf(fmaxf(var, 0.f) + EPS);
        const float y0 = (acc[k][0] - mu) * rstd * g2[0] + b2[0], y1 = (acc[k][1] - mu) * rstd * g2[1] + b2[1];
        *(unsigned*)(OB + (size_t)(urow0 + k) * 2048 + 1024 + c0) = cvt_pk_bf16(fsilu(y0), fsilu(y1)); }
    BSYNC();
}

__device__ __forceinline__ void attn_unit(LAS unsigned char* lds, const bf16* QB, const bf16* KBp, const bf16* VBp, const float* ck, const float* cv, bf16* AO, int unit, int tid) {
    constexpr int KS = 136, VS = 264;
    LAS bf16* Ks = (LAS bf16*)lds;
    LAS bf16* VTs = (LAS bf16*)(lds + 69632);
    const bool sample = unit >= 256; int n, h, qrow0, nvalid;
    if (!sample) { n = unit >> 6; h = (unit >> 4) & 3; qrow0 = n * 2048 + (unit & 15) * 128; nvalid = 128; }
    else { const int s = unit - 256; n = s >> 2; h = s & 3; qrow0 = MP + n * 8; nvalid = 8; }
    const int lane = tid & 63, w = tid >> 6, fr = lane & 15, fq = lane >> 4;
    { const int key = tid >> 1, half = tid & 1;
      if (!sample) { const bf16* kp = KBp + ((size_t)(n * 256 + key)) * XDIM + h * 128 + 64 * half; const bf16* vp = VBp + ((size_t)(n * 256 + key)) * XDIM + h * 128 + 64 * half;
#pragma unroll
          for (int i = 0; i < 8; ++i) *(LAS v4u*)(Ks + key * KS + 64 * half + 8 * i) = *(const v4u*)(kp + 8 * i);
#pragma unroll
          for (int i = 0; i < 8; ++i) { const v4u a = *(const v4u*)(vp + 8 * i); const unsigned ww[4] = {a.x, a.y, a.z, a.w};
#pragma unroll
              for (int j = 0; j < 4; ++j) { VTs[(64 * half + 8 * i + 2 * j) * VS + key] = (bf16)(ww[j] & 0xffffu); VTs[(64 * half + 8 * i + 2 * j + 1) * VS + key] = (bf16)(ww[j] >> 16); } }
      } else { const float* kp = ck + (((size_t)n * 256 + key) * 4 + h) * 128 + 64 * half; const float* vp = cv + (((size_t)n * 256 + key) * 4 + h) * 128 + 64 * half;
#pragma unroll
          for (int i = 0; i < 8; ++i) { const f32x4 a = *(const f32x4*)(kp + 8 * i), b = *(const f32x4*)(kp + 8 * i + 4); v4u o; o.x = cvt_pk_bf16(a[0], a[1]); o.y = cvt_pk_bf16(a[2], a[3]); o.z = cvt_pk_bf16(b[0], b[1]); o.w = cvt_pk_bf16(b[2], b[3]); *(LAS v4u*)(Ks + key * KS + 64 * half + 8 * i) = o; }
#pragma unroll
          for (int i = 0; i < 16; ++i) { const f32x4 a = *(const f32x4*)(vp + 4 * i);
#pragma unroll
              for (int j = 0; j < 4; ++j) VTs[(64 * half + 4 * i + j) * VS + key] = (bf16)f2bf(a[j]); } } }
    BSYNC();
    const bool active = !sample || w == 0;
    f32x4 sc[16]; float rsum[4];
    if (active) {
        const int qr = fr < nvalid ? fr : 0; const bf16* qp = QB + (size_t)(qrow0 + (sample ? 0 : 16 * w) + qr) * XDIM + h * 128 + 8 * fq;
        bf16x8 qf[4];
#pragma unroll
        for (int ks = 0; ks < 4; ++ks) qf[ks] = *(const bf16x8*)(qp + 32 * ks);
#pragma unroll
        for (int nt = 0; nt < 16; ++nt) { sc[nt] = (f32x4){0.f, 0.f, 0.f, 0.f};
#pragma unroll
            for (int ks = 0; ks < 4; ++ks) { const bf16x8 b = *(const LAS bf16x8*)(Ks + (16 * nt + fr) * KS + 32 * ks + 8 * fq); sc[nt] = __builtin_amdgcn_mfma_f32_16x16x32_bf16(qf[ks], b, sc[nt], 0, 0, 0); } }
#pragma unroll
        for (int r = 0; r < 4; ++r) { float m = sc[0][r];
#pragma unroll
            for (int nt = 1; nt < 16; ++nt) m = fmaxf(m, sc[nt][r]);
            m = fmaxf(m, __shfl_xor(m, 1)); m = fmaxf(m, __shfl_xor(m, 2)); m = fmaxf(m, __shfl_xor(m, 4)); m = fmaxf(m, __shfl_xor(m, 8));
            float s = 0.f;
#pragma unroll
            for (int nt = 0; nt < 16; ++nt) { const float p = fexp(sc[nt][r] - m); sc[nt][r] = p; s += p; }
            s += __shfl_xor(s, 1); s += __shfl_xor(s, 2); s += __shfl_xor(s, 4); s += __shfl_xor(s, 8); rsum[r] = s; }
    }
    BSYNC();
    if (active) {
        LAS bf16* Pw = (LAS bf16*)(lds + w * 8448);
#pragma unroll
        for (int nt = 0; nt < 16; ++nt)
#pragma unroll
            for (int r = 0; r < 4; ++r) Pw[(4 * fq + r) * VS + 16 * nt + fr] = (bf16)f2bf(sc[nt][r]);
        LDS_WAIT(); asm volatile("" ::: "memory");
        f32x4 oc[8];
#pragma unroll
        for (int dt = 0; dt < 8; ++dt) oc[dt] = (f32x4){0.f, 0.f, 0.f, 0.f};
#pragma unroll
        for (int ks = 0; ks < 8; ++ks) { const bf16x8 a = *(const LAS bf16x8*)(Pw + fr * VS + 32 * ks + 8 * fq);
#pragma unroll
            for (int dt = 0; dt < 8; ++dt) { const bf16x8 b = *(const LAS bf16x8*)(VTs + (16 * dt + fr) * VS + 32 * ks + 8 * fq); oc[dt] = __builtin_amdgcn_mfma_f32_16x16x32_bf16(a, b, oc[dt], 0, 0, 0); } }
#pragma unroll
        for (int r = 0; r < 4; ++r) { const int ql = 4 * fq + r; if (ql < nvalid) { const float inv = 1.f / rsum[r]; const size_t row = (size_t)(qrow0 + (sample ? 0 : 16 * w) + ql);
#pragma unroll
                for (int dt = 0; dt < 8; ++dt) AO[row * XDIM + h * 128 + 16 * dt + fr] = (bf16)f2bf(oc[dt][r] * inv); } }
    }
    BSYNC();
}

constexpr int N_PHASES = 17;
__global__ void __launch_bounds__(NTHR, 2) mk_fwd(Args args) {
    extern __shared__ __attribute__((aligned(16))) unsigned char lds_raw[];
    LAS unsigned char* lds = (LAS unsigned char*)lds_raw;
    volatile LAS unsigned* MISC = (volatile LAS unsigned*)(lds + MISC_OFF);
    const int tid = threadIdx.x, lane = tid & 63, wave = __builtin_amdgcn_readfirstlane(tid >> 6);
    const int G = gridDim.x, bx = blockIdx.x;
    unsigned char* ws = args.ws; float* out = args.out;
    unsigned* ctl = (unsigned*)(ws + WS_CTL);
    if (tid < 64) MISC[tid] = 0u;
    __syncthreads();
    XcdBarrier bar; bar.bar = ctl + CW_BAR; bar.x = 0; bar.st = nullptr;
#if !MK_PER_PHASE
    bar = xcd_barrier_post(ctl + CW_BAR, MISC + 8);
#define GRID_BAR() xcd_barrier(bar)
#else
#define GRID_BAR() do {} while (0)
#endif
    const int lo = args.ph_lo, hi = args.ph_hi;
#define IN(k) (lo <= (k) && (k) < hi)
#define SEAM(k) do { if (IN(k) && IN((k) + 1)) GRID_BAR(); } while (0)
    const float* x_prompt = args.in[0]; const float* x_sample = args.in[1]; const float* mem_prompt = args.in[2];
    const float* state_hgrn = args.in[3]; const float* state_conv = args.in[4]; const float* cache_k = args.in[5]; const float* cache_v = args.in[6];
    bf16* Wgu1 = (bf16*)(ws + WS_WGU1); bf16* Wd1 = (bf16*)(ws + WS_WD1); bf16* Win = (bf16*)(ws + WS_WIN); bf16* Wout = (bf16*)(ws + WS_WOUT);
    bf16* Wq = (bf16*)(ws + WS_WQ); bf16* Wkv = (bf16*)(ws + WS_WKV); bf16* Wo = (bf16*)(ws + WS_WO); bf16* Wgu2 = (bf16*)(ws + WS_WGU2); bf16* Wd2 = (bf16*)(ws + WS_WD2);
    bf16* XA = (bf16*)(ws + WS_XA); bf16* MN = (bf16*)(ws + WS_MN); float* X = (float*)(ws + WS_X); bf16* H = (bf16*)(ws + WS_H);
    bf16* QH = (bf16*)(ws + WS_QH); bf16* VH = (bf16*)(ws + WS_VH); bf16* GH = (bf16*)(ws + WS_GH); float* LOGF = (float*)(ws + WS_LOGF);
    float* U = (float*)(ws + WS_U); bf16* OB = (bf16*)(ws + WS_OB); float* DS = (float*)(ws + WS_DS); bf16* SST = (bf16*)(ws + WS_SST); float* DEC = (float*)(ws + WS_DEC);
    bf16* KB = (bf16*)(ws + WS_KB); bf16* VB = (bf16*)(ws + WS_VB); bf16* QB = (bf16*)(ws + WS_QB); bf16* AO = (bf16*)(ws + WS_AO);
    const int gw = bx * NWAVES + wave, NGW = G * NWAVES;

    if (IN(0)) {
        LAS float* scr = (LAS float*)(lds + wave * 16384);
        constexpr int I_GU = 32 * 176, I_D = 88 * 64, I_IN = 32 * 192, I_OUT = 32 * 64, I_Q = 32 * 16, I_O = 8 * 64;
        constexpr int NITEMS = 6 * I_GU + I_IN + I_OUT + 3 * I_Q + I_O;
        static_assert(I_D == I_GU, "items");
        for (int it = gw; it < NITEMS; it += NGW) {
            int r = it;
            if (r < 3 * I_GU) { const int which = r / I_GU; r -= which * I_GU;
                if (which < 2) { const int kb = r / 176, nb = r % 176; p0_transpose_item(which == 0 ? args.in[8] : args.in[9], DM, DFF, Wgu1, map_pair(32 * nb, which), scr, 64 * kb, 32 * nb, lane); }
                else { const int kb = r / 64, nb = r % 64; p0_transpose_item(args.in[10], DFF, DM, Wd1, 32 * nb, scr, 64 * kb, 32 * nb, lane); }
                continue; }
            r -= 3 * I_GU;
            if (r < 3 * I_GU) { const int which = r / I_GU; r -= which * I_GU;
                if (which < 2) { const int kb = r / 176, nb = r % 176; p0_transpose_item(which == 0 ? args.in[27] : args.in[28], DM, DFF, Wgu2, map_pair(32 * nb, which), scr, 64 * kb, 32 * nb, lane); }
                else { const int kb = r / 64, nb = r % 64; p0_transpose_item(args.in[29], DFF, DM, Wd2, 32 * nb, scr, 64 * kb, 32 * nb, lane); }
                continue; }
            r -= 3 * I_GU;
            if (r < I_IN) { const int kb = r / 192, nb = r % 192, n0 = 32 * nb; const int dr = n0 < 4096 ? n0 : (n0 < 5120 ? 4096 + map_pair(n0 - 4096, 0) : 4096 + map_pair(n0 - 5120, 1));
                p0_transpose_item(args.in[12], DM, DIN, Win, dr, scr, 64 * kb, n0, lane); continue; }
            r -= I_IN;
            if (r < I_OUT) { const int kb = r / 64, nb = r % 64; p0_transpose_item(args.in[19], DM, DM, Wout, 32 * nb, scr, 64 * kb, 32 * nb, lane); continue; }
            r -= I_OUT;
            if (r < 3 * I_Q) { const int which = r / I_Q; r -= which * I_Q; const int kb = r / 16, nb = r % 16;
                p0_transpose_item(which == 0 ? args.in[22] : (which == 1 ? args.in[23] : args.in[24]), DM, XDIM, which == 0 ? Wq : Wkv, (which == 2 ? 512 : 0) + 32 * nb, scr, 64 * kb, 32 * nb, lane); continue; }
            r -= 3 * I_Q;
            { const int kb = r / 64, nb = r % 64; p0_transpose_item(args.in[25], XDIM, DM, Wo, 32 * nb, scr, 64 * kb, 32 * nb, lane); }
        }
        for (int m = gw; m < MT; m += NGW) { const float* src = m < MP ? x_prompt + (size_t)m * DM : x_sample + (size_t)(m - MP) * DM; rms_row_bf16(src, args.in[7], XA + (size_t)m * DM, X + (size_t)m * DM, lane); }
        for (int m = gw; m < MS; m += NGW) rms_row_bf16(mem_prompt + (size_t)m * DM, args.in[21], MN + (size_t)m * DM, nullptr, lane);
    }
    SEAM(0);
    if (IN(1)) {
        { pg8::Gemm g{XA, Wgu1, MT, 2 * DFF, DM}; pg8::StaticOrder S; S.init(MT, 2 * DFF, G, bx); EpiSwiGLU E{H, DFF};
          pg8::gemm_phase<EpiSwiGLU, pg8::StaticOrder, true, true>(lds + RING_OFF, g, S, E); }
        { pg8::Gemm g{MN, Wkv, MS, 2 * XDIM, DM}; pg8::StaticOrder S; S.init(MS, 2 * XDIM, G, G - 1 - bx); EpiKV E{out + O_MKP, out + O_MVP, KB, VB};
          pg8::gemm_phase<EpiKV, pg8::StaticOrder, true, true>(lds + RING_OFF, g, S, E); }
    }
    SEAM(1);
    if (IN(2)) { pg8::Gemm g{H, Wd1, MT, DM, DFF}; pg8::StaticOrder S; S.init(MT, DM, G, bx); EpiResid E{X, DM, 0.5f};
        pg8::gemm_phase<EpiResid, pg8::StaticOrder, true, true>(lds + RING_OFF, g, S, E); }
    SEAM(2);
    if (IN(3)) { for (int m = gw; m < MT; m += NGW) rms_row_bf16(X + (size_t)m * DM, args.in[11], XA + (size_t)m * DM, nullptr, lane); }
    SEAM(3);
    if (IN(4)) { pg8::Gemm g{XA, Win, MT, DIN, DM}; pg8::StaticOrder S; S.init(MT, DIN, G, bx); EpiWin E{QH, VH, GH, LOGF, U, args.in[13]};
        pg8::gemm_phase<EpiWin, pg8::StaticOrder, true, true>(lds + RING_OFF, g, S, E); }
    SEAM(4);
    if (IN(5)) {
        for (int t = bx; t < 1024; t += G) hgrn_chunk_state(lds, LOGF, VH, DS, DEC, t, tid);
        for (int t = bx; t < 1024; t += G) hgrn_sample(lds, LOGF, QH, VH, GH, state_hgrn, out + O_SHS, args.in[14], OB, t, tid);
        for (int t = bx; t < 1152; t += G) conv_task(lds, U, state_conv, args.in[15], args.in[16], args.in[17], args.in[18], OB, t, tid);
        const int gt = bx * NTHR + tid, NGT = G * NTHR;
        for (int i = gt; i < 4 * 30 * 256; i += NGT) { const int n = i / 7680, rem = i % 7680, r = rem >> 8, c4 = rem & 255;
            *(f32x4*)(out + O_SCP + (size_t)i * 4) = *(const f32x4*)(U + ((size_t)(n * 2048 + 2018 + r)) * 1024 + 4 * c4); }
        for (int i = gt; i < 128 * 30 * 256; i += NGT) { const int n = i / 7680, rem = i % 7680, r = rem >> 8, c4 = rem & 255;
            const float* src = r < 22 ? state_conv + ((size_t)(n * 30 + 8 + r)) * 1024 + 4 * c4 : U + ((size_t)(MP + n * 8 + r - 22)) * 1024 + 4 * c4;
            *(f32x4*)(out + O_SCS + (size_t)i * 4) = *(const f32x4*)src; }
    }
    SEAM(5);
    if (IN(6)) {
        const int gt = bx * NTHR + tid, NGT = G * NTHR;
        for (int i = gt; i < 32 * 4096; i += NGT) { const int nh = i >> 12, q4 = i & 4095, d = q4 >> 5, e4 = q4 & 31; f32x4 S = (f32x4){0.f, 0.f, 0.f, 0.f};
#pragma unroll 8
            for (int c = 0; c < 32; ++c) { const size_t task = (size_t)nh * 32 + c; u32x2 w; w.x = cvt_pk_bf16(S[0], S[1]); w.y = cvt_pk_bf16(S[2], S[3]);
                *(u32x2*)(SST + task * 16384 + d * 128 + 4 * e4) = w;
                const f32x4 dc = *(const f32x4*)(DEC + task * 128 + 4 * e4), ds = *(const f32x4*)(DS + task * 16384 + d * 128 + 4 * e4); S = dc * S + ds; }
#pragma unroll
            for (int k = 0; k < 4; ++k) out[O_SHP + (size_t)nh * 16384 + (4 * e4 + k) * 128 + d] = S[k]; }
    }
    SEAM(6);
    if (IN(7)) { for (int t = bx; t < 1024; t += G) hgrn_chunk_out(lds, LOGF, QH, VH, GH, SST, args.in[14], OB, t, tid); }
    SEAM(7);
    if (IN(8)) { pg8::Gemm g{OB, Wout, MT, DM, DM}; pg8::StaticOrder S; S.init(MT, DM, G, bx); EpiResid E{X, DM, 1.0f};
        pg8::gemm_phase<EpiResid, pg8::StaticOrder, true, true>(lds + RING_OFF, g, S, E); }
    SEAM(8);
    if (IN(9)) { for (int m = gw; m < MT; m += NGW) rms_row_bf16(X + (size_t)m * DM, args.in[20], XA + (size_t)m * DM, nullptr, lane); }
    SEAM(9);
    if (IN(10)) { pg8::Gemm g{XA, Wq, MT, XDIM, DM}; pg8::StaticOrder S; S.init(MT, XDIM, G, bx); pg8::EpiBf16<0> E{QB, XDIM, nullptr, XDIM, 0, 0.08838834764831845f};
        pg8::gemm_phase<pg8::EpiBf16<0>, pg8::StaticOrder, true, true>(lds + RING_OFF, g, S, E); }
    SEAM(10);
    if (IN(11)) { for (int u = bx; u < 768; u += G) attn_unit(lds, QB, KB, VB, cache_k, cache_v, AO, u, tid); }
    SEAM(11);
    if (IN(12)) { pg8::Gemm g{AO, Wo, MT, DM, XDIM}; pg8::StaticOrder S; S.init(MT, DM, G, bx); EpiResid E{X, DM, 1.0f};
        pg8::gemm_phase<EpiResid, pg8::StaticOrder, true, true>(lds + RING_OFF, g, S, E); }
    SEAM(12);
    if (IN(13)) { for (int m = gw; m < MT; m += NGW) rms_row_bf16(X + (size_t)m * DM, args.in[26], XA + (size_t)m * DM, nullptr, lane); }
    SEAM(13);
    if (IN(14)) { pg8::Gemm g{XA, Wgu2, MT, 2 * DFF, DM}; pg8::StaticOrder S; S.init(MT, 2 * DFF, G, bx); EpiSwiGLU E{H, DFF};
        pg8::gemm_phase<EpiSwiGLU, pg8::StaticOrder, true, true>(lds + RING_OFF, g, S, E); }
    SEAM(14);
    if (IN(15)) { pg8::Gemm g{H, Wd2, MT, DM, DFF}; pg8::StaticOrder S; S.init(MT, DM, G, bx); EpiResid E{X, DM, 0.5f};
        pg8::gemm_phase<EpiResid, pg8::StaticOrder, true, true>(lds + RING_OFF, g, S, E); }
    SEAM(15);
    if (IN(16)) { for (int m = gw; m < MT; m += NGW) rms_row_f32(X + (size_t)m * DM, args.in[30], out + O_Y + (size_t)m * DM, lane); }
#undef IN
#undef SEAM
}

extern "C" void kernel_launch(void* const* d_in, const int* in_sizes, int n_in, void* d_out, int out_size, void* d_ws, size_t ws_size, hipStream_t stream) {
    static int grid = 0;
    if (grid == 0) {
        if (n_in != 31 || (size_t)out_size != O_END || ws_size < WS_END) { fprintf(stderr, "kernel_launch: unexpected sizes n_in %d out %d ws %zu\n", n_in, out_size, ws_size); grid = -1; return; }
        int dev = 0, cus = 0, per_cu = 0;
        if (hipGetDevice(&dev) != hipSuccess || hipDeviceGetAttribute(&cus, hipDeviceAttributeMultiprocessorCount, dev) != hipSuccess) { grid = -1; return; }
        if (hipFuncSetAttribute((const void*)mk_fwd, hipFuncAttributeMaxDynamicSharedMemorySize, LDS_BYTES) != hipSuccess) { fprintf(stderr, "kernel_launch: hipFuncSetAttribute failed\n"); grid = -1; return; }
        if (hipOccupancyMaxActiveBlocksPerMultiprocessor(&per_cu, (const void*)mk_fwd, NTHR, LDS_BYTES) != hipSuccess || per_cu < 1) { fprintf(stderr, "kernel_launch: occupancy query says %d\n", per_cu); (void)hipGetLastError(); grid = -1; return; }
        grid = cus;
    }
    if (grid < 0) return;
    if (hipMemsetAsync((char*)d_ws + WS_CTL, 0, CTL_ZERO_BYTES, stream) != hipSuccess) return;
    Args a{};
    for (int i = 0; i < 31; ++i) a.in[i] = (const float*)d_in[i];
    a.out = (float*)d_out; a.ws = (unsigned char*)d_ws;
#if MK_PER_PHASE
    for (int p = 0; p < N_PHASES; ++p) { a.ph_lo = p; a.ph_hi = p + 1; a.li = p; hipLaunchKernelGGL(mk_fwd, dim3(grid), dim3(NTHR), LDS_BYTES, stream, a); }
#else
    a.ph_lo = 0; a.ph_hi = N_PHASES; a.li = 0;
    hipLaunchKernelGGL(mk_fwd, dim3(grid), dim3(NTHR), LDS_BYTES, stream, a);
#endif
}
```

```cpp
#include <hip/hip_runtime.h>
#include <cstdio>
#include <cstdint>
#ifndef MK_PER_PHASE
#define MK_PER_PHASE 0
#endif
#define GAS __attribute__((address_space(1)))
#define LAS __attribute__((address_space(3)))
typedef unsigned short bf16;
typedef unsigned v4u __attribute__((ext_vector_type(4)));
typedef float f32x4 __attribute__((ext_vector_type(4)));
typedef short bf16x8 __attribute__((ext_vector_type(8)));
typedef GAS unsigned gu32;
typedef GAS unsigned long long gu64;
#define RLX_AGENT __ATOMIC_RELAXED, __HIP_MEMORY_SCOPE_AGENT
#define LDS_WAIT() asm volatile("s_waitcnt lgkmcnt(0)" ::: "memory")
#define VM_WAIT() asm volatile("s_waitcnt vmcnt(0)" ::: "memory")
__device__ __forceinline__ unsigned long long rt() { return __builtin_amdgcn_s_memrealtime(); }
__device__ __forceinline__ unsigned f2bf(float f) { unsigned u = __builtin_bit_cast(unsigned, f); return (u + 0x7fffu + ((u >> 16) & 1u)) >> 16; }
__device__ __forceinline__ unsigned pk2(float lo, float hi) { return f2bf(lo) | (f2bf(hi) << 16); }
namespace pg8 {
#define PG8_LAS __attribute__((address_space(3)))
typedef unsigned short bf16_t;
typedef short bf16x8 __attribute__((ext_vector_type(8)));
typedef float f32x4 __attribute__((ext_vector_type(4)));
typedef unsigned u32x4 __attribute__((ext_vector_type(4)));
constexpr int BM = 256, BK = 64, HALF = 128, HTB = HALF * BK * 2  , STAGE_BYTES = 8 * HTB, NXCD = 8, WGM = 8;

__host__ __device__ __forceinline__ int lds_byte(int r, int c) { const int st = (r >> 4) * 2 + (c >> 5), rr = r & 15, cc = c & 31, ob = rr * 64 + cc * 2; return st * 1024 + (ob ^ (((ob >> 9) & 1) << 5)); }
__host__ __device__ __forceinline__ void stage_rc(int b, int& R, int& C) { const int st = b / 1024, sb = b % 1024, swz = sb ^ (((sb >> 9) & 1) << 5); R = (st >> 1) * 16 + swz / 64; C = (st & 1) * 32 + (swz % 64) / 2; }
__host__ __device__ __forceinline__ int perm32(int rho) { const int n = rho >> 4, i = rho & 15; return 8 * (i >> 2) + 4 * n + (i & 3); }

struct Unit { int pm, pn, k0, nk, split; };
struct Gemm { const bf16_t* A; const bf16_t* Bt; int M, N, K; };

struct StaticOrder {
    int nM, nN, nwg, G, c, ntk;
    __host__ __device__ __forceinline__ void init(int M, int N, int G_, int c_, int K_) { nM = M / BM; nN = N / BM; nwg = nM * nN; G = G_; c = c_; ntk = K_ / BK; }
    __host__ __device__ __forceinline__ void tile_of(int wgid, Unit& u) const { { const int q = nwg / NXCD, r = nwg % NXCD, xcd = wgid % NXCD, off = wgid / NXCD; wgid = (xcd < r ? xcd * (q + 1) : r * (q + 1) + (xcd - r) * q) + off; }
        const int nig = WGM * nN, gid = wgid / nig, fm = gid * WGM, gsz = (nM - fm) < WGM ? (nM - fm) : WGM; u.pm = fm + ((wgid % nig) % gsz); u.pn = (wgid % nig) / gsz; }
    __host__ __device__ __forceinline__ bool next(int i, Unit& u) const {
        const long L = (long)i * G + c; if (L >= nwg) return false;
        int wgid = (int)L; { const int q = nwg / NXCD, r = nwg % NXCD, xcd = wgid % NXCD, off = wgid / NXCD; wgid = (xcd < r ? xcd * (q + 1) : r * (q + 1) + (xcd - r) * q) + off; }
        const int nig = WGM * nN, gid = wgid / nig, fm = gid * WGM, gsz = (nM - fm) < WGM ? (nM - fm) : WGM;
        u.pm = fm + ((wgid % nig) % gsz); u.pn = (wgid % nig) / gsz; u.k0 = 0; u.nk = ntk; u.split = 0; return true;
    }
    __device__ __forceinline__ void a_ready(const Unit&) const {}
    __device__ __forceinline__ void done(const Unit&) const {}
};
struct SplitOrder : StaticOrder {
    int F, R, ns, base, extra, all;
    __host__ __device__ __forceinline__ void init(int M, int N, int G_, int c_, int K_) { StaticOrder::init(M, N, G_, c_, K_); all = 0; F = nwg / G; R = nwg - F * G; ns = 1; base = ntk; extra = 0;
        if (R > 0) { ns = G / R; if (ns > ntk / 4) ns = ntk / 4; if (ns < 1) ns = 1; base = (ntk / (2 * ns)) * 2; extra = (ntk / 2) % ns; } }
    __host__ __device__ __forceinline__ bool next(int i, Unit& u) const {
        if (i < F) { if (i * G + c >= nwg) return false; tile_of(i * G + c, u); u.k0 = 0; u.nk = ntk; u.split = all ? 1 + R * ns + (i * G + c) : 0; return true; }
        if (i > F || c >= R * ns) return false;
        const int sp = c / R; tile_of(F * G + (c % R), u); u.k0 = sp * base + 2 * (sp < extra ? sp : extra); u.nk = base + (sp < extra ? 2 : 0); u.split = ns > 1 ? 1 + (c % R) * ns + sp : 0; return true;
    }
};


__device__ __forceinline__ unsigned cvt_pk_bf16(float lo, float hi) { unsigned r; asm volatile("v_cvt_pk_bf16_f32 %0, %1, %2" : "=v"(r) : "v"(lo), "v"(hi)); return r; }
typedef float f32x2 __attribute__((ext_vector_type(2)));
__device__ __forceinline__ f32x2 gelu_pk(f32x2 v) {
    const f32x2 av = __builtin_elementwise_abs(v), d = av * 0.2316418882f + 1.0f;
    f32x2 t; t.x = __builtin_amdgcn_rcpf(d.x); t.y = __builtin_amdgcn_rcpf(d.y);
    f32x2 q = t * 0.5307027145f + (-0.7265760135f); q = q * t + 0.7107068705f; q = q * t + (-0.142248368f); q = q * t + 0.127414796f; q = q * t;
    const f32x2 s = (v * v) * (-0.72134752044f);
    f32x2 e; e.x = __builtin_amdgcn_exp2f(s.x); e.y = __builtin_amdgcn_exp2f(s.y);
    const f32x2 m = v * (q * e), r = v - m;
    f32x2 o; o.x = v.x < 0.f ? m.x : r.x; o.y = v.y < 0.f ? m.y : r.y; return o;
}

template <int ACT  > struct EpiBf16 {
    static constexpr bool PERM = true, AFTER_DRAIN = false; static_assert(ACT == 0 || ACT == 1, "EpiBf16: ACT is 0 (none) or 1 (gelu_pk)");
    bf16_t* O; int ldc; const float* bias; int split_cols; size_t split_stride; float scale0;
    __device__ __forceinline__ void operator()(const f32x4 (&acc)[2][2][4][2], const Unit& u, int wr, int wc, int fr, int fq) const {
        const int row0 = u.pm * BM + wr * 64 + fr; int colt = u.pn * BM; bf16_t* base = O;
        float sc = 1.f; if (split_cols) { const int t = colt / split_cols; base += (size_t)t * split_stride; colt -= t * split_cols; if (t == 0) sc = scale0; }
        const int col0 = colt + wc * 32 + 8 * fq, bcol0 = u.pn * BM + wc * 32 + 8 * fq;
        f32x4 bv[2][2];
#pragma unroll
        for (int bj = 0; bj < 2; ++bj)
#pragma unroll
            for (int n = 0; n < 2; ++n) bv[bj][n] = bias ? *(const f32x4*)(bias + bcol0 + bj * HALF + 4 * n) : (f32x4){0.f, 0.f, 0.f, 0.f};
#pragma unroll
        for (int ai = 0; ai < 2; ++ai)
#pragma unroll
            for (int m = 0; m < 4; ++m) { bf16_t* rowp = base + (size_t)(row0 + ai * HALF + m * 16) * ldc + col0;
#pragma unroll
                for (int bj = 0; bj < 2; ++bj) { f32x4 v0 = acc[ai][bj][m][0] + bv[bj][0], v1 = acc[ai][bj][m][1] + bv[bj][1];
                    if (ACT == 1) { f32x2 a = gelu_pk((f32x2){v0[0], v0[1]}), b = gelu_pk((f32x2){v0[2], v0[3]}), c = gelu_pk((f32x2){v1[0], v1[1]}), d = gelu_pk((f32x2){v1[2], v1[3]});
                        v0 = (f32x4){a.x, a.y, b.x, b.y}; v1 = (f32x4){c.x, c.y, d.x, d.y}; }
                    v0 = v0 * sc; v1 = v1 * sc; u32x4 w; w.x = cvt_pk_bf16(v0[0], v0[1]); w.y = cvt_pk_bf16(v0[2], v0[3]); w.z = cvt_pk_bf16(v1[0], v1[1]); w.w = cvt_pk_bf16(v1[2], v1[3]);
                    *(u32x4*)(rowp + bj * HALF) = w; } }
    }
};

template <class Epi, class Sched, bool ALIGN_EPI = false, bool SP2 = false>
__device__ __forceinline__ void gemm_phase(PG8_LAS unsigned char* lds, const Gemm g, const Sched& S, const Epi& E) {
    const int tid = threadIdx.x, wid = __builtin_amdgcn_readfirstlane(tid >> 6), lane = tid & 63, wr = wid >> 2, wc = wid & 3, fr = lane & 15, fq = lane >> 4;
    const int K = g.K;
    unsigned voffA[2], voffB[2];
#pragma unroll
    for (int i = 0; i < 2; ++i) { int R, C; stage_rc(tid * 16 + i * 8192, R, C); const int Rb = Epi::PERM ? ((R & ~31) + perm32(R & 31)) : R;
        voffA[i] = (unsigned)(R * K + C) * 2u; voffB[i] = (unsigned)(Rb * K + C) * 2u; }
    const size_t kstep = (size_t)(BK * 2);
    const size_t hstep = (size_t)HALF * K * 2;
    const size_t tstep = 2 * hstep;
    const unsigned ldsw = (unsigned)wid * 1024u;
    const int aoff = lds_byte(wr * 64 + fr, fq * 8), boff = lds_byte(wc * 32 + fr, fq * 8);
#define PG8_SA(b, h) (((b) * 2 + (h)) * HTB)
#define PG8_SB(b, h) ((4 + (b) * 2 + (h)) * HTB)
#define PG8_STAGE(bufoff, gbase, voff) do { _Pragma("unroll") for (int _i = 0; _i < 2; ++_i) \
        __builtin_amdgcn_global_load_lds((const unsigned*)((const char*)(gbase) + (voff)[_i]), (PG8_LAS unsigned*)(lds + (bufoff) + ldsw + _i * 8192), 16, 0, 0); } while (0)
#define PG8_LDA(dst, b, h) do { _Pragma("unroll") for (int m = 0; m < 4; ++m) _Pragma("unroll") for (int k = 0; k < 2; ++k) dst[m][k] = *(const PG8_LAS bf16x8*)(lds + PG8_SA(b, h) + aoff + m * 2048 + k * 1024); } while (0)
#define PG8_LDB(dst, b, h) do { _Pragma("unroll") for (int n = 0; n < 2; ++n) _Pragma("unroll") for (int k = 0; k < 2; ++k) dst[n][k] = *(const PG8_LAS bf16x8*)(lds + PG8_SB(b, h) + boff + n * 2048 + k * 1024); } while (0)
#define PG8_MMA(ai, bj, At, Bt) do { __builtin_amdgcn_s_setprio(1); _Pragma("unroll") for (int m = 0; m < 4; ++m) _Pragma("unroll") for (int n = 0; n < 2; ++n) _Pragma("unroll") for (int k = 0; k < 2; ++k) \
        acc[ai][bj][m][n] = __builtin_amdgcn_mfma_f32_16x16x32_bf16(Bt[n][k], At[m][k], acc[ai][bj][m][n], 0, 0, 0); __builtin_amdgcn_s_setprio(0); } while (0)
#define PG8_WAIT_V(n) asm volatile("s_waitcnt vmcnt(" #n ")" ::: "memory")
#define PG8_WAIT_L(n) asm volatile("s_waitcnt lgkmcnt(" #n ")" ::: "memory")
#define PG8_BAR __builtin_amdgcn_s_barrier()
#define PG8_SCHED __builtin_amdgcn_sched_barrier(0)
    Unit cur, nxt; int ui = 0;
    if (!S.next(0, cur)) return;
    f32x4 acc[2][2][4][2];
#pragma unroll
    for (int a = 0; a < 2; ++a)
#pragma unroll
        for (int b = 0; b < 2; ++b)
#pragma unroll
            for (int m = 0; m < 4; ++m)
#pragma unroll
                for (int n = 0; n < 2; ++n) acc[a][b][m][n] = (f32x4){0.f, 0.f, 0.f, 0.f};
    bf16x8 At[4][2], B0[2][2], B1[2][2];
    const char* cA = (const char*)g.A + (size_t)cur.pm * tstep + (size_t)cur.k0 * kstep; const char* cB = (const char*)g.Bt + (size_t)cur.pn * tstep + (size_t)cur.k0 * kstep;
    S.a_ready(cur);
    if constexpr (SP2) {
        PG8_STAGE(PG8_SB(0, 0), cB, voffB); PG8_STAGE(PG8_SB(0, 1), cB + hstep, voffB); PG8_STAGE(PG8_SA(0, 0), cA, voffA); PG8_STAGE(PG8_SA(0, 1), cA + hstep, voffA);
        if (wr == 1) PG8_BAR;
        PG8_WAIT_V(2); PG8_BAR;
        PG8_STAGE(PG8_SB(1, 0), cB + kstep, voffB); PG8_STAGE(PG8_SA(1, 0), cA + kstep, voffA); PG8_STAGE(PG8_SB(1, 1), cB + hstep + kstep, voffB);
        PG8_WAIT_V(6); PG8_BAR;
    } else {
        PG8_STAGE(PG8_SB(0, 0), cB, voffB); PG8_STAGE(PG8_SA(0, 0), cA, voffA); PG8_STAGE(PG8_SB(0, 1), cB + hstep, voffB); PG8_STAGE(PG8_SA(0, 1), cA + hstep, voffA);
        if (wr == 1) PG8_BAR;
        PG8_WAIT_V(4); PG8_BAR;
        PG8_STAGE(PG8_SB(1, 0), cB + kstep, voffB); PG8_STAGE(PG8_SA(1, 0), cA + kstep, voffA); PG8_STAGE(PG8_SB(1, 1), cB + hstep + kstep, voffB);
        PG8_WAIT_V(6); PG8_BAR;
    }
    for (;;) {
        const bool has_next = S.next(ui + 1, nxt);
        const char* nA = has_next ? (const char*)g.A + (size_t)nxt.pm * tstep + (size_t)nxt.k0 * kstep : cA; const char* nB = has_next ? (const char*)g.Bt + (size_t)nxt.pn * tstep + (size_t)nxt.k0 * kstep : cB;
        const int nt = cur.nk;
        for (int t = 0; t < nt; t += 2) {
            const bool last = (t == nt - 2);
            const char* a1 = cA + (size_t)(t + 1) * kstep;
            const char* a2 = last ? nA : cA + (size_t)(t + 2) * kstep; const char* b2 = last ? nB : cB + (size_t)(t + 2) * kstep;
            const char* a3 = a2 + kstep; const char* b3 = b2 + kstep;
            if (last && has_next) S.a_ready(nxt);
            if constexpr (SP2) {
            PG8_LDB(B0, 0, 0); PG8_LDB(B1, 0, 1); PG8_SCHED; PG8_LDA(At, 0, 0); PG8_STAGE(PG8_SA(1, 1), a1 + hstep, voffA);
            PG8_WAIT_V(8); PG8_WAIT_L(0); PG8_BAR; PG8_MMA(0, 0, At, B0); PG8_MMA(0, 1, At, B1); PG8_BAR; PG8_SCHED;
            PG8_LDA(At, 0, 1); PG8_STAGE(PG8_SB(0, 0), b2, voffB); PG8_STAGE(PG8_SB(0, 1), b2 + hstep, voffB); PG8_STAGE(PG8_SA(0, 0), a2, voffA);
            PG8_WAIT_V(8); PG8_WAIT_L(0); PG8_BAR; PG8_MMA(1, 0, At, B0); PG8_MMA(1, 1, At, B1); PG8_BAR; PG8_SCHED;
            PG8_LDB(B0, 1, 0); PG8_LDB(B1, 1, 1); PG8_SCHED; PG8_LDA(At, 1, 0); PG8_STAGE(PG8_SA(0, 1), a2 + hstep, voffA);
            PG8_WAIT_V(8); PG8_WAIT_L(0); PG8_BAR; PG8_MMA(0, 0, At, B0); PG8_MMA(0, 1, At, B1); PG8_BAR; PG8_SCHED;
            PG8_LDA(At, 1, 1); PG8_STAGE(PG8_SB(1, 0), b3, voffB); PG8_STAGE(PG8_SB(1, 1), b3 + hstep, voffB); PG8_STAGE(PG8_SA(1, 0), a3, voffA);
            PG8_WAIT_V(8); PG8_WAIT_L(0); PG8_BAR; PG8_MMA(1, 0, At, B0); PG8_MMA(1, 1, At, B1); PG8_BAR; PG8_SCHED;
            } else {
            PG8_LDB(B0, 0, 0); PG8_SCHED; PG8_LDA(At, 0, 0); PG8_STAGE(PG8_SA(1, 1), a1 + hstep, voffA);
            PG8_WAIT_L(8); PG8_BAR; PG8_WAIT_L(0); PG8_MMA(0, 0, At, B0); PG8_BAR; PG8_SCHED;
            PG8_LDB(B1, 0, 1); PG8_STAGE(PG8_SB(0, 0), b2, voffB);
            PG8_BAR; PG8_WAIT_L(0); PG8_MMA(0, 1, At, B1); PG8_BAR;
            PG8_LDA(At, 0, 1); PG8_STAGE(PG8_SA(0, 0), a2, voffA);
            PG8_BAR; PG8_WAIT_L(0); PG8_MMA(1, 0, At, B0); PG8_BAR; PG8_SCHED;
            PG8_STAGE(PG8_SB(0, 1), b2 + hstep, voffB);
            PG8_WAIT_V(6); PG8_BAR; PG8_MMA(1, 1, At, B1); PG8_BAR;
            PG8_LDB(B0, 1, 0); PG8_SCHED; PG8_LDA(At, 1, 0); PG8_STAGE(PG8_SA(0, 1), a2 + hstep, voffA);
            PG8_WAIT_L(8); PG8_BAR; PG8_WAIT_L(0); PG8_MMA(0, 0, At, B0); PG8_BAR; PG8_SCHED;
            PG8_LDB(B1, 1, 1); PG8_STAGE(PG8_SB(1, 0), b3, voffB);
            PG8_BAR; PG8_WAIT_L(0); PG8_MMA(0, 1, At, B1); PG8_BAR;
            PG8_LDA(At, 1, 1); PG8_STAGE(PG8_SA(1, 0), a3, voffA);
            PG8_BAR; PG8_WAIT_L(0); PG8_MMA(1, 0, At, B0); PG8_BAR; PG8_SCHED;
            PG8_STAGE(PG8_SB(1, 1), b3 + hstep, voffB);
            PG8_WAIT_V(6); PG8_BAR; PG8_MMA(1, 1, At, B1); PG8_BAR;
            }
        }
        if constexpr (ALIGN_EPI) { if (wr == 0) PG8_BAR; }
        if constexpr (!Epi::AFTER_DRAIN) { E(acc, cur, wr, wc, fr, fq); S.done(cur); }
        if (!has_next) break;
#pragma unroll
        for (int a = 0; a < 2; ++a)
#pragma unroll
            for (int b = 0; b < 2; ++b)
#pragma unroll
                for (int m = 0; m < 4; ++m)
#pragma unroll
                    for (int n = 0; n < 2; ++n) acc[a][b][m][n] = (f32x4){0.f, 0.f, 0.f, 0.f};
        cur = nxt; cA = nA; cB = nB; ++ui;
        if constexpr (ALIGN_EPI) { if (wr == 1) PG8_BAR; }
    }
    PG8_WAIT_V(0);
    if constexpr (!ALIGN_EPI) { if (wr == 0) PG8_BAR; }
    PG8_BAR;
    if constexpr (Epi::AFTER_DRAIN) { E.fused(acc, cur, wr, wc, fr, fq, lds, wid, lane); S.done(cur); }
#undef PG8_SA
#undef PG8_SB
#undef PG8_STAGE
#undef PG8_LDA
#undef PG8_LDB
#undef PG8_MMA
#undef PG8_WAIT_V
#undef PG8_WAIT_L
#undef PG8_BAR
#undef PG8_SCHED
}
}
#define XB_TMO      128
#define XB_XCNT(j)  (256  + 64 * (j))
#define XB_XSUB(j)  (1280 + 64 * (j))
#define XB_XGEN(j)  (2304 + 64 * (j))
#define XB_TOP      3328
#define XB_TOPGEN   3392
#define XCD_BAR_WORDS 3456
#define XB_SPIN_CAP (1u << 18)

__device__ __forceinline__ unsigned xb_ld(unsigned* p)              { return __hip_atomic_load(p, __ATOMIC_RELAXED, __HIP_MEMORY_SCOPE_AGENT); }
__device__ __forceinline__ unsigned xb_add(unsigned* p, unsigned v) { return __hip_atomic_fetch_add(p, v, __ATOMIC_RELAXED, __HIP_MEMORY_SCOPE_AGENT); }
__device__ __forceinline__ unsigned xb_xcc_id() { return (unsigned)__builtin_amdgcn_s_getreg((3 << 11) | 20) & 0xFu; }
#define XB_SPIN(cond, bar) do { unsigned _sp = 0; while (cond) { __builtin_amdgcn_s_sleep(1); \
    if ((++_sp & 255u) == 0u) { if (xb_ld(&(bar)[XB_TMO])) break; if (_sp > XB_SPIN_CAP) { atomicAdd(&(bar)[XB_TMO], 1u); break; } } } } while (0)

struct XcdBarrier {
    unsigned* bar; unsigned x;
    volatile LAS unsigned* st;
};

__device__ __forceinline__ XcdBarrier xcd_barrier_post(unsigned* bar, volatile LAS unsigned* st) {
    XcdBarrier b; b.bar = bar; b.x = xb_xcc_id(); b.st = st;
    if (threadIdx.x == 0) (void)xb_add(&bar[XB_XCNT(b.x)], 1u);
    return b;
}
__device__ __forceinline__ void xcd_barrier_complete(unsigned* bar, unsigned x, unsigned& nloc, unsigned& nx) {
    const unsigned G = gridDim.x * gridDim.y * gridDim.z;
    unsigned sum, cnt, mine, sp = 0u;
    for (;;) {
        sum = 0u; cnt = 0u; mine = 0u;
#pragma unroll
        for (unsigned j = 0; j < 16; ++j) { const unsigned c = xb_ld(&bar[XB_XCNT(j)]); sum += c; cnt += (c > 0u) ? 1u : 0u; mine = (j == x) ? c : mine; }
        if (sum == G) break;
        __builtin_amdgcn_s_sleep(1);
        if ((++sp & 255u) == 0u) { if (xb_ld(&bar[XB_TMO])) break; if (sp > XB_SPIN_CAP) { atomicAdd(&bar[XB_TMO], 1u); break; } }
    }
    nloc = mine > 0u ? mine : 1u; nx = cnt > 0u ? cnt : 1u;
}

__device__ __forceinline__ void xcd_barrier(const XcdBarrier& b) {
    asm volatile("s_waitcnt vmcnt(0)" ::: "memory");
    __syncthreads();
    if (threadIdx.x == 0) {
        unsigned* bar = b.bar;
        __builtin_amdgcn_s_waitcnt(0);
        unsigned nloc = b.st[0], nx = b.st[1];
        if (nloc == 0u) { xcd_barrier_complete(bar, b.x, nloc, nx); b.st[0] = nloc; b.st[1] = nx; }
        const unsigned old = xb_add(&bar[XB_XSUB(b.x)], 1u);
        const unsigned gen = old / nloc;
        if (old + 1u == (gen + 1u) * nloc) {
            __builtin_amdgcn_fence(__ATOMIC_RELEASE, "agent");
            asm volatile("s_waitcnt vmcnt(0)" ::: "memory");
            const unsigned og = xb_add(&bar[XB_TOP], 1u);
            const unsigned tg = og / nx;
            if (og + 1u == (tg + 1u) * nx) xb_add(&bar[XB_TOPGEN], 1u);
            else XB_SPIN(xb_ld(&bar[XB_TOPGEN]) == tg, bar);
            __builtin_amdgcn_fence(__ATOMIC_ACQUIRE, "agent");
            xb_add(&bar[XB_XGEN(b.x)], 1u);
            asm volatile("s_waitcnt vmcnt(0)" ::: "memory");
        } else {
            XB_SPIN(xb_ld(&bar[XB_XGEN(b.x)]) == gen, bar);
            __builtin_amdgcn_fence(__ATOMIC_ACQUIRE, "agent");
            asm volatile("s_waitcnt vmcnt(0)" ::: "memory");
        }
    }
    __syncthreads();
}

constexpr int NWAVES = 8, NTHR = 512;
constexpr int DM = 2048, MP = 8192, MS = 1024, MT = MP + MS;
constexpr int DFF = 5632, DIN = 6144, NH = 8, HE = 128, HV = 128, CC = 1024, CW = 31, MEML = 256, XH = 4, XD = 128, XDIM = 512;
constexpr float EPS = 1e-6f;
constexpr size_t O_Y = 0, O_SHP = 18874368, O_SCP = 19398656, O_MKP = 19521536, O_MVP = 20045824, O_SHS = 20570112, O_SCS = 37347328, O_END = 41279488;
constexpr size_t MiB = 1u << 20;
constexpr size_t WS_CTL = 0, CTL_ZERO_BYTES = 1 * MiB;
constexpr size_t WS_WGU1 = 2 * MiB, WS_WD1 = 46 * MiB, WS_WIN = 68 * MiB, WS_WOUT = 92 * MiB, WS_WQ = 100 * MiB, WS_WKV = 102 * MiB, WS_WO = 106 * MiB, WS_WGU2 = 108 * MiB, WS_WD2 = 152 * MiB;
constexpr size_t WS_XA = 174 * MiB, WS_MN = 210 * MiB, WS_X = 214 * MiB, WS_H = 286 * MiB;
constexpr size_t WS_QH = WS_H, WS_VH = WS_H + 18 * MiB, WS_GH = WS_H + 36 * MiB, WS_LOGF = WS_H + 54 * MiB;
constexpr size_t WS_U = 385 * MiB, WS_OB = 421 * MiB, WS_DS = 457 * MiB, WS_SST = 521 * MiB, WS_DEC = 553 * MiB, WS_KB = 554 * MiB, WS_VB = 555 * MiB, WS_QB = 556 * MiB, WS_AO = 565 * MiB, WS_END = 574 * MiB;
constexpr int CW_BAR = 4096;
constexpr size_t WS_SS = 65536;
constexpr int RING_OFF = 0, LDS_BYTES = 147456, MISC_OFF = LDS_BYTES - 256;

typedef unsigned u32x2 __attribute__((ext_vector_type(2)));
__device__ __forceinline__ float bf2f(unsigned short h) { return __builtin_bit_cast(float, (unsigned)h << 16); }
__device__ __forceinline__ float fexp(float x) { return __builtin_amdgcn_exp2f(x * 1.4426950408889634f); }
__device__ __forceinline__ float fsigmoid(float x) { return __builtin_amdgcn_rcpf(1.f + fexp(-x)); }
__device__ __forceinline__ float fsilu(float x) { return x * fsigmoid(x); }
__device__ __forceinline__ float wave_sum(float v) {
#pragma unroll
    for (int o = 1; o < 64; o <<= 1) v += __shfl_xor(v, o);
    return v;
}
using pg8::cvt_pk_bf16;

struct EpiSwiGLU {
    static constexpr bool PERM = true, AFTER_DRAIN = false;
    bf16* H; int ldh; bf16* slab; const float* ss;
    __device__ __forceinline__ void operator()(const f32x4 (&acc)[2][2][4][2], const pg8::Unit& u, int wr, int wc, int fr, int fq) const {
        if (u.split) {
            bf16* sb = slab + (size_t)(u.split - 1) * 65536 + (size_t)(wr * 64 + fr) * 256 + wc * 32 + 8 * fq;
#pragma unroll
            for (int ai = 0; ai < 2; ++ai)
#pragma unroll
                for (int m = 0; m < 4; ++m)
#pragma unroll
                    for (int bj = 0; bj < 2; ++bj) { const f32x4 v0 = acc[ai][bj][m][0], v1 = acc[ai][bj][m][1]; v4u w;
                        w.x = cvt_pk_bf16(v0[0], v0[1]); w.y = cvt_pk_bf16(v0[2], v0[3]); w.z = cvt_pk_bf16(v1[0], v1[1]); w.w = cvt_pk_bf16(v1[2], v1[3]);
                        *(v4u*)(sb + (ai * 128 + m * 16) * 256 + bj * 128) = w; }
            return;
        }
        const int row0 = u.pm * 256 + wr * 64 + fr, col0 = u.pn * 128 + wc * 32 + 8 * fq;
        float sq[2][4];
#pragma unroll
        for (int ai = 0; ai < 2; ++ai)
#pragma unroll
            for (int m = 0; m < 4; ++m) sq[ai][m] = ss ? ss[row0 + ai * 128 + m * 16] : 0.f;
#pragma unroll
        for (int ai = 0; ai < 2; ++ai)
#pragma unroll
            for (int m = 0; m < 4; ++m) {
                bf16* rowp = H + (size_t)(row0 + ai * 128 + m * 16) * ldh + col0;
                const float rs = ss ? __builtin_amdgcn_rsqf(sq[ai][m] * (1.f / DM) + EPS) : 1.f;
                const f32x4 g0 = acc[ai][0][m][0] * rs, g1 = acc[ai][0][m][1] * rs, u0 = acc[ai][1][m][0] * rs, u1 = acc[ai][1][m][1] * rs;
                v4u w;
                w.x = cvt_pk_bf16(fsilu(g0[0]) * u0[0], fsilu(g0[1]) * u0[1]); w.y = cvt_pk_bf16(fsilu(g0[2]) * u0[2], fsilu(g0[3]) * u0[3]);
                w.z = cvt_pk_bf16(fsilu(g1[0]) * u1[0], fsilu(g1[1]) * u1[1]); w.w = cvt_pk_bf16(fsilu(g1[2]) * u1[2], fsilu(g1[3]) * u1[3]);
                *(v4u*)rowp = w;
            }
    }
};
__device__ __forceinline__ void swiglu_fixup(const bf16* slab, bf16* H, const float* ss, int G, int gt, int NGT) {
    pg8::SplitOrder S; S.init(MT, 2 * DFF, G, 0, DM);
    if (S.R == 0 || S.ns <= 1) return;
    for (int item = gt; item < S.R * 4096; item += NGT) { const int r = item >> 12, row = (item >> 4) & 255, c8 = item & 15; pg8::Unit u; S.tile_of(S.F * G + r, u);
        float g[8], up[8];
#pragma unroll
        for (int i = 0; i < 8; ++i) { g[i] = 0.f; up[i] = 0.f; }
        const bf16* sp = slab + ((size_t)r * S.ns * 256 + row) * 256 + 8 * c8;
        v4u a5[5], b5[5];
#pragma unroll
        for (int q = 0; q < 5; ++q) { const size_t qo = (size_t)(q < S.ns ? q : 0) * 65536; a5[q] = *(const v4u*)(sp + qo); b5[q] = *(const v4u*)(sp + qo + 128); }
        for (int q5 = 5; q5 < S.ns; ++q5) { const v4u a = *(const v4u*)(sp + (size_t)q5 * 65536), b = *(const v4u*)(sp + (size_t)q5 * 65536 + 128); const unsigned aw[4] = {a.x, a.y, a.z, a.w}, bw[4] = {b.x, b.y, b.z, b.w};
#pragma unroll
            for (int i = 0; i < 4; ++i) { g[2 * i] += __builtin_bit_cast(float, aw[i] << 16); g[2 * i + 1] += __builtin_bit_cast(float, aw[i] & 0xffff0000u);
                up[2 * i] += __builtin_bit_cast(float, bw[i] << 16); up[2 * i + 1] += __builtin_bit_cast(float, bw[i] & 0xffff0000u); } }
#pragma unroll
        for (int q = 0; q < 5; ++q) { if (q >= S.ns) continue; const v4u a = a5[q], b = b5[q];
            const unsigned aw[4] = {a.x, a.y, a.z, a.w}, bw[4] = {b.x, b.y, b.z, b.w};
#pragma unroll
            for (int i = 0; i < 4; ++i) { g[2 * i] += __builtin_bit_cast(float, aw[i] << 16); g[2 * i + 1] += __builtin_bit_cast(float, aw[i] & 0xffff0000u);
                up[2 * i] += __builtin_bit_cast(float, bw[i] << 16); up[2 * i + 1] += __builtin_bit_cast(float, bw[i] & 0xffff0000u); } }
        if (ss) { const float rs = 1.f / sqrtf(ss[u.pm * 256 + row] * (1.f / DM) + EPS);
#pragma unroll
            for (int i = 0; i < 8; ++i) { g[i] *= rs; up[i] *= rs; } }
        v4u w; w.x = cvt_pk_bf16(fsilu(g[0]) * up[0], fsilu(g[1]) * up[1]); w.y = cvt_pk_bf16(fsilu(g[2]) * up[2], fsilu(g[3]) * up[3]);
        w.z = cvt_pk_bf16(fsilu(g[4]) * up[4], fsilu(g[5]) * up[5]); w.w = cvt_pk_bf16(fsilu(g[6]) * up[6], fsilu(g[7]) * up[7]);
        *(v4u*)(H + (size_t)(u.pm * 256 + row) * DFF + u.pn * 128 + 8 * c8) = w; }
}
struct EpiResid {
    static constexpr bool PERM = false, AFTER_DRAIN = false;
    float* X; int ldc; float scale; float* slab; bf16* XAo; float* ss;
    __device__ __forceinline__ void operator()(const f32x4 (&acc)[2][2][4][2], const pg8::Unit& u, int wr, int wc, int fr, int fq) const {
        const int rl = wr * 64 + fr, cl = wc * 32 + 4 * fq;
        if (u.split) {
            bf16* sb = (bf16*)slab + (size_t)(u.split - 1) * 65536 + (size_t)rl * 256 + cl;
#pragma unroll
            for (int ai = 0; ai < 2; ++ai)
#pragma unroll
                for (int m = 0; m < 4; ++m)
#pragma unroll
                    for (int bj = 0; bj < 2; ++bj)
#pragma unroll
                        for (int n = 0; n < 2; ++n) { const f32x4 v = acc[ai][bj][m][n] * scale; u32x2 w; w.x = cvt_pk_bf16(v[0], v[1]); w.y = cvt_pk_bf16(v[2], v[3]);
                            *(u32x2*)(sb + (ai * 128 + m * 16) * 256 + bj * 128 + n * 16) = w; }
        } else {
#pragma unroll
            for (int ai = 0; ai < 2; ++ai)
#pragma unroll
                for (int m = 0; m < 4; ++m) {
                    const size_t ro = (size_t)(u.pm * 256 + rl + ai * 128 + m * 16) * ldc + u.pn * 256 + cl; float* rowp = X + ro; float s2 = 0.f;
#pragma unroll
                    for (int bj = 0; bj < 2; ++bj)
#pragma unroll
                        for (int n = 0; n < 2; ++n) { f32x4* p = (f32x4*)(rowp + bj * 128 + n * 16); const f32x4 v = *p + acc[ai][bj][m][n] * scale; *p = v;
                            if (XAo) { u32x2 w; w.x = cvt_pk_bf16(v[0], v[1]); w.y = cvt_pk_bf16(v[2], v[3]); *(u32x2*)(XAo + ro + bj * 128 + n * 16) = w; s2 += (v[0] * v[0] + v[1] * v[1]) + (v[2] * v[2] + v[3] * v[3]); } }
                    if (XAo) { s2 += __shfl_xor(s2, 16); s2 += __shfl_xor(s2, 32); if (fq == 0) __hip_atomic_fetch_add(ss + (u.pm * 256 + rl + ai * 128 + m * 16), s2, __ATOMIC_RELAXED, __HIP_MEMORY_SCOPE_AGENT); }
                }
        }
    }
};
struct EpiKV {
    static constexpr bool PERM = false, AFTER_DRAIN = false;
    float* outK; float* outV; bf16* KB; bf16* VBT;
    __device__ __forceinline__ void operator()(const f32x4 (&acc)[2][2][4][2], const pg8::Unit& u, int wr, int wc, int fr, int fq) const {
        const int row0 = u.pm * 256 + wr * 64 + fr; const bool isv = u.pn >= 2; const int col0 = (u.pn & 1) * 256 + wc * 32 + 4 * fq;
        float* of = isv ? outV : outK;
#pragma unroll
        for (int ai = 0; ai < 2; ++ai)
#pragma unroll
            for (int m = 0; m < 4; ++m) {
                const int row = row0 + ai * 128 + m * 16; const size_t ro = (size_t)row * XDIM + col0;
#pragma unroll
                for (int bj = 0; bj < 2; ++bj)
#pragma unroll
                    for (int n = 0; n < 2; ++n) { const f32x4 v = acc[ai][bj][m][n]; *(f32x4*)(of + ro + bj * 128 + n * 16) = v;
                        if (!isv) { u32x2 w; w.x = cvt_pk_bf16(v[0], v[1]); w.y = cvt_pk_bf16(v[2], v[3]); *(u32x2*)(KB + ro + bj * 128 + n * 16) = w; }
                        else { const int col = col0 + bj * 128 + n * 16; bf16* vt = VBT + ((size_t)(row >> 8) * 512 + col) * 256 + (row & 255);
#pragma unroll
                            for (int i = 0; i < 4; ++i) vt[i * 256] = (bf16)f2bf(v[i]); } }
            }
    }
};
struct EpiWin {
    static constexpr bool PERM = true, AFTER_DRAIN = false;
    bf16* QH; bf16* VH; bf16* GH; float* LOGF; float* U; const float* lbp; const float* ss;
    __device__ __forceinline__ void operator()(const f32x4 (&acc)[2][2][4][2], const pg8::Unit& u, int wr, int wc, int fr, int fq) const {
        const int row0 = u.pm * 256 + wr * 64 + fr; const int ty = u.pn >> 2;
        float sq[2][4];
#pragma unroll
        for (int ai = 0; ai < 2; ++ai)
#pragma unroll
            for (int m = 0; m < 4; ++m) sq[ai][m] = ss[row0 + ai * 128 + m * 16];
        if (ty == 0 || ty == 2 || ty == 3) {
            bf16* dst = QH + (size_t)(ty == 0 ? 0 : ty - 1) * (size_t)(9u << 20); const int col0 = (u.pn & 3) * 256 + wc * 32 + 8 * fq;
#pragma unroll
            for (int ai = 0; ai < 2; ++ai)
#pragma unroll
                for (int m = 0; m < 4; ++m) { const float rs = __builtin_amdgcn_rsqf(sq[ai][m] * (1.f / DM) + EPS); bf16* rowp = dst + (size_t)(row0 + ai * 128 + m * 16) * 1024 + col0;
#pragma unroll
                    for (int bj = 0; bj < 2; ++bj) { f32x4 v0 = acc[ai][bj][m][0] * rs, v1 = acc[ai][bj][m][1] * rs;
                        if (ty != 2) {
#pragma unroll
                            for (int i = 0; i < 4; ++i) { v0[i] = fsilu(v0[i]); v1[i] = fsilu(v1[i]); } }
                        v4u w; w.x = cvt_pk_bf16(v0[0], v0[1]); w.y = cvt_pk_bf16(v0[2], v0[3]); w.z = cvt_pk_bf16(v1[0], v1[1]); w.w = cvt_pk_bf16(v1[2], v1[3]);
                        *(v4u*)(rowp + bj * 128) = w; } }
        } else if (ty == 1) {
            const int col0 = (u.pn & 3) * 256 + wc * 32 + 8 * fq;
            f32x4 lb[2][2];
#pragma unroll
            for (int bj = 0; bj < 2; ++bj)
#pragma unroll
                for (int n = 0; n < 2; ++n) { const f32x4 a0 = *(const f32x4*)(lbp + col0 + bj * 128 + 4 * n), a1 = *(const f32x4*)(lbp + 1024 + col0 + bj * 128 + 4 * n);
#pragma unroll
                    for (int i = 0; i < 4; ++i) lb[bj][n][i] = fsigmoid(a0[i] - a1[i]); }
#pragma unroll
            for (int ai = 0; ai < 2; ++ai)
#pragma unroll
                for (int m = 0; m < 4; ++m) { const float rs = __builtin_amdgcn_rsqf(sq[ai][m] * (1.f / DM) + EPS); float* rowp = LOGF + (size_t)(row0 + ai * 128 + m * 16) * 1024 + col0;
#pragma unroll
                    for (int bj = 0; bj < 2; ++bj)
#pragma unroll
                        for (int n = 0; n < 2; ++n) { const f32x4 z = acc[ai][bj][m][n] * rs; f32x4 o;
#pragma unroll
                            for (int i = 0; i < 4; ++i) { const float l = lb[bj][n][i]; o[i] = __logf(l + (1.f - l) * fsigmoid(z[i])); }
                            *(f32x4*)(rowp + bj * 128 + 4 * n) = o; } }
        } else {
            const int col0 = (u.pn - 16) * 128 + wc * 32 + 8 * fq;
#pragma unroll
            for (int ai = 0; ai < 2; ++ai)
#pragma unroll
                for (int m = 0; m < 4; ++m) { const float rs = __builtin_amdgcn_rsqf(sq[ai][m] * (1.f / DM) + EPS); float* rowp = U + (size_t)(row0 + ai * 128 + m * 16) * 1024 + col0;
#pragma unroll
                    for (int n = 0; n < 2; ++n) { const f32x4 a = acc[ai][0][m][n] * rs, b = acc[ai][1][m][n] * rs; f32x4 o;
#pragma unroll
                        for (int i = 0; i < 4; ++i) o[i] = a[i] * fsigmoid(b[i]);
                        *(f32x4*)(rowp + 4 * n) = o; } }
        }
    }
};

__device__ __forceinline__ void p0_transpose_item(const float* W, int K, int N, bf16* WT, int dst_row0, LAS float* scr, int k0, int n0, int lane, const float* gain = nullptr) {
#pragma unroll 8
    for (int i = 0; i < 32; ++i) { const int kk = 2 * i + (lane >> 5); scr[kk * 33 + (lane & 31)] = __builtin_nontemporal_load(W + (size_t)(k0 + kk) * N + n0 + (lane & 31)); }
    LDS_WAIT(); asm volatile("" ::: "memory");
    const int c = lane & 7;
    f32x4 g0 = (f32x4){1.f, 1.f, 1.f, 1.f}, g1 = g0; if (gain) { g0 = *(const f32x4*)(gain + k0 + 8 * c); g1 = *(const f32x4*)(gain + k0 + 8 * c + 4); }
#pragma unroll
    for (int j = 0; j < 4; ++j) { const int n = (lane >> 3) + 8 * j; const LAS float* s = scr + (8 * c) * 33 + n;
        v4u o; o.x = pk2(s[0 * 33] * g0[0], s[1 * 33] * g0[1]); o.y = pk2(s[2 * 33] * g0[2], s[3 * 33] * g0[3]); o.z = pk2(s[4 * 33] * g1[0], s[5 * 33] * g1[1]); o.w = pk2(s[6 * 33] * g1[2], s[7 * 33] * g1[3]);
        *(v4u*)(WT + (size_t)(dst_row0 + n) * K + k0 + 8 * c) = o; }
    LDS_WAIT(); asm volatile("" ::: "memory");
}
__device__ __forceinline__ int map_pair(int n0, int second) { return 256 * (n0 >> 7) + 128 * second + (n0 & 127); }
__device__ __forceinline__ void rms_row_bf16(const float* xrow, const float* g, bf16* orow, float* copy, int lane) {
    const f32x4* xr = (const f32x4*)xrow + lane; f32x4 v[8]; float s = 0.f;
#pragma unroll
    for (int j = 0; j < 8; ++j) { v[j] = xr[64 * j]; s += (v[j][0] * v[j][0] + v[j][1] * v[j][1]) + (v[j][2] * v[j][2] + v[j][3] * v[j][3]); }
    if (copy) {
#pragma unroll
        for (int j = 0; j < 8; ++j) ((f32x4*)copy + lane)[64 * j] = v[j]; }
    const float r = 1.f / sqrtf(wave_sum(s) * (1.f / DM) + EPS);
    u32x2* o8 = (u32x2*)orow + lane;
#pragma unroll
    for (int j = 0; j < 8; ++j) { const f32x4 gg = ((const f32x4*)g + lane)[64 * j]; u32x2 w; w.x = cvt_pk_bf16(v[j][0] * r * gg[0], v[j][1] * r * gg[1]); w.y = cvt_pk_bf16(v[j][2] * r * gg[2], v[j][3] * r * gg[3]); o8[64 * j] = w; }
}
__device__ __forceinline__ void build_split_table(LAS int* T, int G, int tid) {
    pg8::SplitOrder S; S.init(MT, DM, G, 0, DM);
    for (int i = tid; i < 36 * 8; i += NTHR) T[i] = -1;
    __syncthreads();
    if (tid < S.R) { pg8::Unit u; S.tile_of(S.F * G + tid, u); T[u.pm * 8 + u.pn] = tid; }
    __syncthreads();
}
__device__ __forceinline__ void build_slab_table_all(LAS int* T, int G, int tid) {
    pg8::SplitOrder S; S.init(MT, DM, G, 0, XDIM);
    for (int L = tid; L < S.nwg; L += NTHR) { pg8::Unit u; S.tile_of(L, u); const bool rem = L >= S.F * G; T[u.pm * 8 + u.pn] = rem ? (L - S.F * G) * S.ns : S.R * S.ns + L; T[288 + u.pm * 8 + u.pn] = rem ? S.ns : 1; }
    __syncthreads();
}
template <int MAXNS>
__device__ __forceinline__ void resid_fixup(float* X, bf16* XAo, float* ss, const float* slab, int K, int G, int gw, int NGW, int lane) {
    pg8::SplitOrder S; S.init(MT, DM, G, 0, K);
    for (int item = gw; item < S.R * 256; item += NGW) { const int r = item >> 8, rr = item & 255; pg8::Unit u; S.tile_of(S.F * G + r, u);
        const size_t ro = (size_t)(u.pm * 256 + rr) * DM + u.pn * 256 + 4 * lane; f32x4 v = *(const f32x4*)(X + ro);
        const bf16* sp = (const bf16*)slab + ((size_t)r * S.ns * 256 + rr) * 256 + 4 * lane;
        u32x2 wq[MAXNS];
#pragma unroll
        for (int q = 0; q < MAXNS; ++q) wq[q] = *(const u32x2*)(sp + (size_t)(q < S.ns ? q : 0) * 65536);
        for (int q = MAXNS; q < S.ns; ++q) { const u32x2 w = *(const u32x2*)(sp + (size_t)q * 65536);
            v[0] += __builtin_bit_cast(float, w.x << 16); v[1] += __builtin_bit_cast(float, w.x & 0xffff0000u); v[2] += __builtin_bit_cast(float, w.y << 16); v[3] += __builtin_bit_cast(float, w.y & 0xffff0000u); }
#pragma unroll
        for (int q = 0; q < MAXNS; ++q) { if (q >= S.ns) continue; const u32x2 w = wq[q];
            v[0] += __builtin_bit_cast(float, w.x << 16); v[1] += __builtin_bit_cast(float, w.x & 0xffff0000u); v[2] += __builtin_bit_cast(float, w.y << 16); v[3] += __builtin_bit_cast(float, w.y & 0xffff0000u); }
        *(f32x4*)(X + ro) = v; u32x2 w; w.x = cvt_pk_bf16(v[0], v[1]); w.y = cvt_pk_bf16(v[2], v[3]); *(u32x2*)(XAo + ro) = w;
        const float s2 = wave_sum((v[0] * v[0] + v[1] * v[1]) + (v[2] * v[2] + v[3] * v[3])); if (lane == 0) __hip_atomic_fetch_add(ss + (u.pm * 256 + rr), s2, __ATOMIC_RELAXED, __HIP_MEMORY_SCOPE_AGENT); }
}
template <bool OUTF>
__device__ __forceinline__ void rms_row_fix(float* xrow, const float* g, void* orow, const LAS int* T, const float* slab, int ns, int m, int lane) {
    f32x4* xr = (f32x4*)xrow + lane; f32x4 v[8]; float s = 0.f; const int pm = m >> 8, rr = m & 255;
#pragma unroll
    for (int j = 0; j < 8; ++j) v[j] = xr[64 * j];
#pragma unroll
    for (int j = 0; j < 8; ++j) { const int t = T[pm * 8 + j];
        if (t >= 0) { const int cnt = ns > 0 ? ns : T[288 + pm * 8 + j]; const bf16* sp = (const bf16*)slab + ((size_t)t * (ns > 0 ? ns : 1) * 256 + rr) * 256 + 4 * lane;
            for (int q = 0; q < cnt; ++q) { const u32x2 w = *(const u32x2*)(sp + (size_t)q * 65536);
                v[j][0] += __builtin_bit_cast(float, w.x << 16); v[j][1] += __builtin_bit_cast(float, w.x & 0xffff0000u); v[j][2] += __builtin_bit_cast(float, w.y << 16); v[j][3] += __builtin_bit_cast(float, w.y & 0xffff0000u); }
            if (!OUTF) xr[64 * j] = v[j]; } }
#pragma unroll
    for (int j = 0; j < 8; ++j) s += (v[j][0] * v[j][0] + v[j][1] * v[j][1]) + (v[j][2] * v[j][2] + v[j][3] * v[j][3]);
    const float r = 1.f / sqrtf(wave_sum(s) * (1.f / DM) + EPS);
#pragma unroll
    for (int j = 0; j < 8; ++j) { const f32x4 gg = ((const f32x4*)g + lane)[64 * j];
        if (OUTF) __builtin_nontemporal_store(v[j] * r * gg, (f32x4*)orow + lane + 64 * j);
        else { u32x2 w; w.x = cvt_pk_bf16(v[j][0] * r * gg[0], v[j][1] * r * gg[1]); w.y = cvt_pk_bf16(v[j][2] * r * gg[2], v[j][3] * r * gg[3]); ((u32x2*)orow + lane)[64 * j] = w; } }
}

__device__ __forceinline__ void rms_row_final(f32x4 (&v)[8], const float* g, float* orow, const LAS int* T, const float* slab, int ns, int m, int lane) {
    float s = 0.f; const int pm = m >> 8, rr = m & 255;
#pragma unroll
    for (int j = 0; j < 8; ++j) { const int t = T[pm * 8 + j];
        if (t >= 0) { const bf16* sp = (const bf16*)slab + ((size_t)t * ns * 256 + rr) * 256 + 4 * lane;
            for (int q = 0; q < ns; ++q) { const u32x2 w = *(const u32x2*)(sp + (size_t)q * 65536);
                v[j][0] += __builtin_bit_cast(float, w.x << 16); v[j][1] += __builtin_bit_cast(float, w.x & 0xffff0000u); v[j][2] += __builtin_bit_cast(float, w.y << 16); v[j][3] += __builtin_bit_cast(float, w.y & 0xffff0000u); } } }
#pragma unroll
    for (int j = 0; j < 8; ++j) s += (v[j][0] * v[j][0] + v[j][1] * v[j][1]) + (v[j][2] * v[j][2] + v[j][3] * v[j][3]);
    const float r = 1.f / sqrtf(wave_sum(s) * (1.f / DM) + EPS);
#pragma unroll
    for (int j = 0; j < 8; ++j) { const f32x4 gg = ((const f32x4*)g + lane)[64 * j]; __builtin_nontemporal_store(v[j] * r * gg, (f32x4*)orow + lane + 64 * j); }
}

struct Args { const float* in[31]; float* out; unsigned char* ws; int ph_lo, ph_hi, li, pad; };

#define BSYNC() __syncthreads()

__device__ __forceinline__ void hg_cumsum_regs(const LAS float* Lb, LAS float* tot, int e, int part, float (&bv)[16], float (&pre)[5]) {
    float v[16];
#pragma unroll
    for (int i = 0; i < 16; ++i) v[i] = Lb[(16 * part + i) * 128 + e];
    float a = 0.f;
#pragma unroll
    for (int i = 0; i < 16; ++i) { a += v[i]; bv[i] = a; }
    tot[part * 128 + e] = a;
    BSYNC();
    const float t0 = tot[e], t1 = tot[128 + e], t2 = tot[256 + e], t3 = tot[384 + e];
    pre[0] = 0.f; pre[1] = t0; pre[2] = t0 + t1; pre[3] = (t0 + t1) + t2; pre[4] = ((t0 + t1) + t2) + t3;
    const float off = part == 0 ? pre[0] : (part == 1 ? pre[1] : (part == 2 ? pre[2] : pre[3]));
#pragma unroll
    for (int i = 0; i < 16; ++i) bv[i] += off;
}
__device__ __forceinline__ void hg_load_vt(const bf16* VH, int r0, int h, LAS bf16* VT, int tid) {
    const int s = tid >> 3, ch = tid & 7; const bf16* src = VH + (size_t)(r0 + s) * 1024 + h * 128 + 16 * ch;
    const v4u a = *(const v4u*)src, b = *(const v4u*)(src + 8);
    const unsigned w[8] = {a.x, a.y, a.z, a.w, b.x, b.y, b.z, b.w};
#pragma unroll
    for (int i = 0; i < 8; ++i) { VT[(16 * ch + 2 * i) * 72 + s] = (bf16)(w[i] & 0xffffu); VT[(16 * ch + 2 * i + 1) * 72 + s] = (bf16)(w[i] >> 16); }
}

__device__ __forceinline__ void hgrn_cs_load(const float* LOGF, const bf16* VH, int task, int tid, f32x4 (&lf)[4], v4u& va, v4u& vb) {
    const int n = task >> 8, h = (task >> 5) & 7, c = task & 31, r0 = n * 2048 + c * 64;
#pragma unroll
    for (int i = 0; i < 4; ++i) { const int idx = tid + 512 * i, s = idx >> 5, e4 = idx & 31; lf[i] = *(const f32x4*)(LOGF + (size_t)(r0 + s) * 1024 + h * 128 + 4 * e4); }
    const bf16* src = VH + (size_t)(r0 + (tid >> 3)) * 1024 + h * 128 + 16 * (tid & 7); va = *(const v4u*)src; vb = *(const v4u*)(src + 8);
}
__device__ __forceinline__ void hgrn_chunk_states(LAS unsigned char* lds, const float* LOGF, const bf16* VH, float* DS, float* DEC, int first, int last, int G, int tid) {
    LAS float* Lb = (LAS float*)lds; LAS float* Kk = (LAS float*)(lds + 32768); LAS bf16* KdT = (LAS bf16*)(lds + 65536); LAS bf16* VT = (LAS bf16*)(lds + 83968);
    if (first >= last) return;
    const int lane = tid & 63, w = tid >> 6, fr = lane & 15, fq = lane >> 4;
    f32x4 lf[4]; v4u va, vb;
    hgrn_cs_load(LOGF, VH, first, tid, lf, va, vb);
    for (int task = first; task < last; task += G) {
        __builtin_amdgcn_sched_barrier(0);
#pragma unroll
        for (int i = 0; i < 4; ++i) { const int idx = tid + 512 * i, s = idx >> 5, e4 = idx & 31; const f32x4 v = lf[i];
            *(LAS f32x4*)(Lb + s * 128 + 4 * e4) = v; f32x4 k; k[0] = 1.f - fexp(v[0]); k[1] = 1.f - fexp(v[1]); k[2] = 1.f - fexp(v[2]); k[3] = 1.f - fexp(v[3]); *(LAS f32x4*)(Kk + s * 128 + 4 * e4) = k; }
        { const int s = tid >> 3, ch = tid & 7; const unsigned wv[8] = {va.x, va.y, va.z, va.w, vb.x, vb.y, vb.z, vb.w};
#pragma unroll
          for (int i = 0; i < 8; ++i) { VT[(16 * ch + 2 * i) * 72 + s] = (bf16)(wv[i] & 0xffffu); VT[(16 * ch + 2 * i + 1) * 72 + s] = (bf16)(wv[i] >> 16); } }
        __builtin_amdgcn_sched_barrier(0);
        if (task + G < last) hgrn_cs_load(LOGF, VH, task + G, tid, lf, va, vb);
        __builtin_amdgcn_sched_barrier(0);
        BSYNC();
        { const int e = tid & 127, part = __builtin_amdgcn_readfirstlane(tid >> 7); float bv[16], pre[5], kd[16];
          hg_cumsum_regs(Lb, (LAS float*)(lds + 102400), e, part, bv, pre); const float bend = pre[4];
#pragma unroll
          for (int i = 0; i < 16; ++i) { const int s = 16 * part + i; kd[i] = Kk[s * 128 + e] * fexp(bend - bv[i]); }
          v4u o0, o1; o0.x = cvt_pk_bf16(kd[0], kd[1]); o0.y = cvt_pk_bf16(kd[2], kd[3]); o0.z = cvt_pk_bf16(kd[4], kd[5]); o0.w = cvt_pk_bf16(kd[6], kd[7]);
          o1.x = cvt_pk_bf16(kd[8], kd[9]); o1.y = cvt_pk_bf16(kd[10], kd[11]); o1.z = cvt_pk_bf16(kd[12], kd[13]); o1.w = cvt_pk_bf16(kd[14], kd[15]);
          *(LAS v4u*)(KdT + e * 72 + 16 * part) = o0; *(LAS v4u*)(KdT + e * 72 + 16 * part + 8) = o1;
          if (part == 0) DEC[(size_t)task * 128 + e] = fexp(bend); }
        BSYNC();
        f32x4 acc[8];
#pragma unroll
        for (int et = 0; et < 8; ++et) acc[et] = (f32x4){0.f, 0.f, 0.f, 0.f};
#pragma unroll
        for (int ks = 0; ks < 2; ++ks) { const bf16x8 a = *(const LAS bf16x8*)(VT + (16 * w + fr) * 72 + 32 * ks + 8 * fq);
#pragma unroll
            for (int et = 0; et < 8; ++et) { const bf16x8 b = *(const LAS bf16x8*)(KdT + (16 * et + fr) * 72 + 32 * ks + 8 * fq); acc[et] = __builtin_amdgcn_mfma_f32_16x16x32_bf16(a, b, acc[et], 0, 0, 0); } }
        float* dst = DS + (size_t)task * 16384;
#pragma unroll
        for (int et = 0; et < 8; ++et)
#pragma unroll
            for (int r = 0; r < 4; ++r) dst[(16 * w + 4 * fq + r) * 128 + 16 * et + fr] = acc[et][r];
        BSYNC();
    }
}

__device__ __forceinline__ void hgrn_co_load_a(const float* LOGF, const bf16* VH, int task, int tid, f32x4 (&lf)[4], v4u& va, v4u& vb) {
    const int n = task >> 8, h = (task >> 5) & 7, c = task & 31, r0 = n * 2048 + c * 64;
#pragma unroll
    for (int i = 0; i < 4; ++i) { const int idx = tid + 512 * i, s = idx >> 5, e4 = idx & 31; lf[i] = *(const f32x4*)(LOGF + (size_t)(r0 + s) * 1024 + h * 128 + 4 * e4); }
    const bf16* vsrc = VH + (size_t)(r0 + (tid >> 3)) * 1024 + h * 128 + 16 * (tid & 7); va = *(const v4u*)vsrc; vb = *(const v4u*)(vsrc + 8);
}
__device__ __forceinline__ void hgrn_co_load_b(const bf16* QH, const bf16* SST, int task, int tid, float (&qv)[16], v4u (&sst)[4]) {
    const int n = task >> 8, h = (task >> 5) & 7, c = task & 31, r0 = n * 2048 + c * 64;
#pragma unroll
    for (int i = 0; i < 16; ++i) qv[i] = bf2f(QH[(size_t)(r0 + 16 * (tid >> 7) + i) * 1024 + h * 128 + (tid & 127)]);
#pragma unroll
    for (int i = 0; i < 4; ++i) { const int idx = tid + 512 * i, d = idx >> 4, ch = idx & 15; sst[i] = *(const v4u*)(SST + (size_t)task * 16384 + d * 128 + 8 * ch); }
}
__device__ __forceinline__ void hgrn_chunk_outs(LAS unsigned char* lds, const float* LOGF, const bf16* QH, const bf16* VH, const bf16* GH, const bf16* SST, const float* gnorm, bf16* OB, int first, int last, int G, int tid) {
    LAS float* Lb = (LAS float*)lds; LAS bf16* SsT = (LAS bf16*)lds; LAS bf16* Qb = (LAS bf16*)(lds + 34816); LAS bf16* Qp = (LAS bf16*)(lds + 52224);
    LAS bf16* Kt = (LAS bf16*)(lds + 69632); LAS bf16* VT = (LAS bf16*)(lds + 113152); LAS bf16* Ab = (LAS bf16*)(lds + 131584); LAS float* red = (LAS float*)(lds + 140800);
    if (first >= last) return;
    const int lane = tid & 63, w = tid >> 6, fr = lane & 15, fq = lane >> 4;
    const int tt = w & 3, dh = w >> 2;
    f32x4 lf[4]; v4u sst[4], va, vb; float qv[16]; float gn[4];
#pragma unroll
    for (int k = 0; k < 4; ++k) gn[k] = gnorm[16 * (4 * dh + k) + fr];
    hgrn_co_load_a(LOGF, VH, first, tid, lf, va, vb); hgrn_co_load_b(QH, SST, first, tid, qv, sst);
    for (int task = first; task < last; task += G) {
    const int n = task >> 8, h = (task >> 5) & 7, c = task & 31, r0 = n * 2048 + c * 64;
    bf16 ghv[4][4];
#pragma unroll
    for (int r = 0; r < 4; ++r)
#pragma unroll
        for (int k = 0; k < 4; ++k) ghv[r][k] = GH[(size_t)(r0 + 16 * tt + 4 * fq + r) * 1024 + h * 128 + 16 * (4 * dh + k) + fr];
    __builtin_amdgcn_sched_barrier(0);
#pragma unroll
    for (int i = 0; i < 4; ++i) { const int idx = tid + 512 * i, s = idx >> 5, e4 = idx & 31; *(LAS f32x4*)(Lb + s * 128 + 4 * e4) = lf[i]; }
    { const int s = tid >> 3, ch = tid & 7; const unsigned wv[8] = {va.x, va.y, va.z, va.w, vb.x, vb.y, vb.z, vb.w};
#pragma unroll
      for (int i = 0; i < 8; ++i) { VT[(16 * ch + 2 * i) * 72 + s] = (bf16)(wv[i] & 0xffffu); VT[(16 * ch + 2 * i + 1) * 72 + s] = (bf16)(wv[i] >> 16); } }
    for (int i = tid; i < 64 * 72 / 2; i += NTHR) ((LAS unsigned*)Ab)[i] = 0u;
    __builtin_amdgcn_sched_barrier(0);
    if (task + G < last) hgrn_co_load_a(LOGF, VH, task + G, tid, lf, va, vb);
    __builtin_amdgcn_sched_barrier(0);
    BSYNC();
    { const int e = tid & 127, part = __builtin_amdgcn_readfirstlane(tid >> 7); float bv[16], pre[5];
      hg_cumsum_regs(Lb, (LAS float*)(lds + 141312), e, part, bv, pre);
      const float rmine = part == 0 ? pre[0] : (part == 1 ? pre[1] : (part == 2 ? pre[2] : pre[3]));
      const float c0 = fexp(rmine); float cK[4];
#pragma unroll
      for (int ip = 0; ip < 4; ++ip) cK[ip] = fexp(pre[ip] - rmine);
#pragma unroll
      for (int i = 0; i < 16; ++i) { const int t = 16 * part + i; const float b = bv[i]; const float bprev = i > 0 ? bv[i - 1] : rmine;
          const float k = 1.f - fexp(b - bprev); const float e1 = fexp(rmine - b); const float qp = qv[i] * __builtin_amdgcn_rcpf(e1); const float ke = k * e1;
          Qb[t * 136 + e] = (bf16)f2bf(qp * c0); Qp[t * 136 + e] = (bf16)f2bf(qp);
#pragma unroll
          for (int ip = 0; ip < 4; ++ip) if (ip >= part) Kt[(8 * ip * (ip + 1) + t) * 136 + e] = (bf16)f2bf(ke * cK[ip]); } }
    BSYNC();
#pragma unroll
    for (int i = 0; i < 4; ++i) { const int idx = tid + 512 * i, d = idx >> 4, ch = idx & 15; *(LAS v4u*)(SsT + d * 136 + 8 * ch) = sst[i]; }
    for (int tl = w; tl < 10; tl += 8) { const int i = tl < 1 ? 0 : (tl < 3 ? 1 : (tl < 6 ? 2 : 3)), j = tl - (i * (i + 1)) / 2;
        f32x4 a4 = (f32x4){0.f, 0.f, 0.f, 0.f};
#pragma unroll
        for (int ks = 0; ks < 4; ++ks) { const bf16x8 a = *(const LAS bf16x8*)(Qp + (16 * i + fr) * 136 + 32 * ks + 8 * fq); const bf16x8 b = *(const LAS bf16x8*)(Kt + (8 * i * (i + 1) + 16 * j + fr) * 136 + 32 * ks + 8 * fq);
            a4 = __builtin_amdgcn_mfma_f32_16x16x32_bf16(a, b, a4, 0, 0, 0); }
#pragma unroll
        for (int r = 0; r < 4; ++r) { float v = a4[r]; if (i == j && fr > 4 * fq + r) v = 0.f; Ab[(16 * i + 4 * fq + r) * 72 + 16 * j + fr] = (bf16)f2bf(v); } }
    __builtin_amdgcn_sched_barrier(0);
    if (task + G < last) hgrn_co_load_b(QH, SST, task + G, tid, qv, sst);
    __builtin_amdgcn_sched_barrier(0);
    BSYNC();
    f32x4 acc[4];
#pragma unroll
    for (int k = 0; k < 4; ++k) acc[k] = (f32x4){0.f, 0.f, 0.f, 0.f};
#pragma unroll
    for (int ks = 0; ks < 2; ++ks) { const bf16x8 a = *(const LAS bf16x8*)(Ab + (16 * tt + fr) * 72 + 32 * ks + 8 * fq);
#pragma unroll
        for (int k = 0; k < 4; ++k) { const bf16x8 b = *(const LAS bf16x8*)(VT + (16 * (4 * dh + k) + fr) * 72 + 32 * ks + 8 * fq); acc[k] = __builtin_amdgcn_mfma_f32_16x16x32_bf16(a, b, acc[k], 0, 0, 0); } }
#pragma unroll
    for (int ks = 0; ks < 4; ++ks) { const bf16x8 a = *(const LAS bf16x8*)(Qb + (16 * tt + fr) * 136 + 32 * ks + 8 * fq);
#pragma unroll
        for (int k = 0; k < 4; ++k) { const bf16x8 b = *(const LAS bf16x8*)(SsT + (16 * (4 * dh + k) + fr) * 136 + 32 * ks + 8 * fq); acc[k] = __builtin_amdgcn_mfma_f32_16x16x32_bf16(a, b, acc[k], 0, 0, 0); } }
#pragma unroll
    for (int r = 0; r < 4; ++r) { float ss = 0.f;
#pragma unroll
        for (int k = 0; k < 4; ++k) ss += acc[k][r] * acc[k][r];
        ss += __shfl_xor(ss, 1); ss += __shfl_xor(ss, 2); ss += __shfl_xor(ss, 4); ss += __shfl_xor(ss, 8);
        if (fr == 0) red[(16 * tt + 4 * fq + r) * 2 + dh] = ss; }
    BSYNC();
#pragma unroll
    for (int r = 0; r < 4; ++r) { const int t = 16 * tt + 4 * fq + r; const float rs = 1.f / sqrtf((red[t * 2] + red[t * 2 + 1]) * (1.f / 128.f) + EPS); const size_t row = (size_t)(r0 + t);
#pragma unroll
        for (int k = 0; k < 4; ++k) { const int d = 16 * (4 * dh + k) + fr; const float v = acc[k][r] * rs * gn[k] * bf2f(ghv[r][k]); OB[row * 2048 + h * 128 + d] = (bf16)f2bf(v); } }
    BSYNC();
    }
}

__device__ __forceinline__ void hgrn_sample_load(const float* LOGF, const bf16* QH, const bf16* VH, const bf16* GH, const float* S0g, int task, int tid, f32x4 (&s0)[8], unsigned& gg, float (&sm)[6]) {
    const int n = task >> 3, h = task & 7, r0 = MP + n * 8;
    const float* sp = S0g + ((size_t)task * 128 + 8 * (tid >> 5)) * 128 + 4 * (tid & 31);
#pragma unroll
    for (int k = 0; k < 8; ++k) s0[k] = __builtin_nontemporal_load((const f32x4*)(sp + k * 128));
    gg = *(const unsigned*)(GH + (size_t)(r0 + (tid >> 6)) * 1024 + h * 128 + 2 * (tid & 63));
#pragma unroll
    for (int i = 0; i < 2; ++i) { const int idx = tid + 512 * i, t = idx >> 7, e = idx & 127; const size_t g = (size_t)(r0 + t) * 1024 + h * 128 + e; sm[3 * i] = LOGF[g]; sm[3 * i + 1] = bf2f(QH[g]); sm[3 * i + 2] = bf2f(VH[g]); }
}
__device__ __forceinline__ void hgrn_samples(LAS unsigned char* lds, const float* LOGF, const bf16* QH, const bf16* VH, const bf16* GH, const float* S0g, float* Sout, const float* gnorm, bf16* OB, int first, int last, int G, int tid) {
    if (first >= last) return;
    f32x4 s0[8]; unsigned gg, ggn = 0u; float sm[6];
    const float gn0 = gnorm[2 * (tid & 63)], gn1 = gnorm[2 * (tid & 63) + 1];
    hgrn_sample_load(LOGF, QH, VH, GH, S0g, first, tid, s0, gg, sm);
    for (int task = first; task < last; task += G) {
    LAS float* bb = (LAS float*)lds; LAS float* qb = (LAS float*)(lds + 4096); LAS float* kd = (LAS float*)(lds + 8192); LAS float* vv = (LAS float*)(lds + 12288);
    LAS float* dec = (LAS float*)(lds + 16384); LAS float* Am = (LAS float*)(lds + 16896); LAS float* qraw = (LAS float*)(lds + 17408); LAS float* kraw = (LAS float*)(lds + 21504);
    LAS float* red = (LAS float*)(lds + 32768);
    const int n = task >> 3, h = task & 7, r0 = MP + n * 8;
    __builtin_amdgcn_sched_barrier(0);
#pragma unroll
    for (int i = 0; i < 2; ++i) { const int idx = tid + 512 * i;
        const float lf = sm[3 * i]; bb[idx] = lf; kraw[idx] = 1.f - fexp(lf); qraw[idx] = sm[3 * i + 1]; vv[idx] = sm[3 * i + 2]; }
    BSYNC();
    if (tid < 128) { const int e = tid; float a = 0.f; float bl[8];
#pragma unroll
        for (int t = 0; t < 8; ++t) { a += bb[t * 128 + e]; bl[t] = a; bb[t * 128 + e] = a; }
        dec[e] = fexp(a);
#pragma unroll
        for (int t = 0; t < 8; ++t) { qb[t * 128 + e] = qraw[t * 128 + e] * fexp(bl[t]); kd[t * 128 + e] = kraw[t * 128 + e] * fexp(a - bl[t]); } }
    BSYNC();
    { const int pair = tid >> 3, t = pair >> 3, s = pair & 7, es = tid & 7; float sum = 0.f;
      if (s <= t) {
#pragma unroll
          for (int i = 0; i < 16; ++i) { const int e = 16 * es + i; sum += qraw[t * 128 + e] * kraw[s * 128 + e] * fexp(bb[t * 128 + e] - bb[s * 128 + e]); } }
      sum += __shfl_xor(sum, 1); sum += __shfl_xor(sum, 2); sum += __shfl_xor(sum, 4);
      if (es == 0) Am[t * 8 + s] = sum; }
    { const int dq = tid & 31, eg = tid >> 5; f32x4 v4[8], po[8];
#pragma unroll
      for (int s = 0; s < 8; ++s) { v4[s] = *(const LAS f32x4*)(vv + s * 128 + 4 * dq); po[s] = (f32x4){0.f, 0.f, 0.f, 0.f}; }
      float* op = Sout + ((size_t)task * 128 + 8 * eg) * 128 + 4 * dq;
#pragma unroll
      for (int k = 0; k < 8; ++k) { const int e = 8 * eg + k; f32x4 sn = s0[k] * dec[e];
#pragma unroll
          for (int t = 0; t < 8; ++t) { po[t] += s0[k] * qb[t * 128 + e]; sn += v4[t] * kd[t * 128 + e]; }
          __builtin_nontemporal_store(sn, (f32x4*)(op + k * 128)); }
#pragma unroll
      for (int t = 0; t < 8; ++t) *(LAS f32x4*)(red + (eg * 8 + t) * 128 + 4 * dq) = po[t]; }
    __builtin_amdgcn_sched_barrier(0);
    if (task + G < last) hgrn_sample_load(LOGF, QH, VH, GH, S0g, task + G, tid, s0, ggn, sm);
    __builtin_amdgcn_sched_barrier(0);
    BSYNC();
    { const int t = tid >> 6, dp = tid & 63; float o0 = 0.f, o1 = 0.f;
#pragma unroll
      for (int eg = 0; eg < 16; ++eg) { o0 += red[(eg * 8 + t) * 128 + 2 * dp]; o1 += red[(eg * 8 + t) * 128 + 2 * dp + 1]; }
#pragma unroll
      for (int s = 0; s < 8; ++s) { const float a = Am[t * 8 + s]; o0 += a * vv[s * 128 + 2 * dp]; o1 += a * vv[s * 128 + 2 * dp + 1]; }
      const float rs = 1.f / sqrtf(wave_sum(o0 * o0 + o1 * o1) * (1.f / 128.f) + EPS); const size_t row = (size_t)(r0 + t); const int d = 2 * dp;
      *(unsigned*)(OB + row * 2048 + h * 128 + d) = cvt_pk_bf16(o0 * rs * gn0 * bf2f((bf16)(gg & 0xffffu)), o1 * rs * gn1 * bf2f((bf16)(gg >> 16))); }
    BSYNC();
    gg = ggn;
    }
}

typedef float cf32x2 __attribute__((ext_vector_type(2)));
template <bool SAMPLE>
__device__ __forceinline__ void conv_load_rows(const float* U, const float* sconv, int task, int c0, cf32x2 (&rows)[38]) {
    const int n = SAMPLE ? task - 1024 : task >> 8, t0 = SAMPLE ? 0 : (task & 255) * 8; const int urow0 = SAMPLE ? MP + n * 8 : n * 2048 + t0;
#pragma unroll
    for (int r = 0; r < 38; ++r) {
        if (SAMPLE) { rows[r] = (r < 30) ? *(const cf32x2*)(sconv + ((size_t)n * 30 + (r < 30 ? r : 0)) * 1024 + c0) : *(const cf32x2*)(U + (size_t)(urow0 + r - 30) * 1024 + c0); }
        else { const int dr = t0 + r - 30; const int rowc = n * 2048 + (dr > 0 ? dr : 0); rows[r] = *(const cf32x2*)(U + (size_t)rowc * 1024 + c0); }
    }
}
template <bool SAMPLE>
__device__ __forceinline__ void conv_tasks(LAS unsigned char* lds, const float* U, const float* sconv, const float* cw, const float* cb, const float* lg, const float* lbeta, bf16* OB, int first, int last, int G, int tid) {
    LAS float* red = (LAS float*)lds;
    LAS float* tot = (LAS float*)(lds + 1024);
    if (first >= last) return;
    const int c0 = 2 * tid, lane = tid & 63, w = tid >> 6;
    typedef cf32x2 f32x2;
    f32x2 wj[31];
#pragma unroll
    for (int j = 0; j < 31; ++j) wj[j] = *(const f32x2*)(cw + j * 1024 + c0);
    const f32x2 bias = *(const f32x2*)(cb + c0), g2 = *(const f32x2*)(lg + c0), b2 = *(const f32x2*)(lbeta + c0);
    f32x2 rows[38];
    conv_load_rows<SAMPLE>(U, sconv, first, c0, rows);
    for (int task = first; task < last; task += G) {
        const int n = SAMPLE ? task - 1024 : task >> 8, t0 = SAMPLE ? 0 : (task & 255) * 8; const int urow0 = SAMPLE ? MP + n * 8 : n * 2048 + t0;
        f32x2 acc[8];
#pragma unroll
        for (int k = 0; k < 8; ++k) acc[k] = bias;
        __builtin_amdgcn_sched_barrier(0);
#pragma unroll
        for (int r = 0; r < 38; ++r) {
            f32x2 v = rows[r];
            if (!SAMPLE && r < 30) v = v * ((t0 + r - 30) >= 0 ? 1.f : 0.f);
#pragma unroll
            for (int k = 0; k < 8; ++k) { const int j = r - k; if (j >= 0 && j <= 30) acc[k] += wj[j] * v; }
        }
        __builtin_amdgcn_sched_barrier(0);
        if (task + G < last) conv_load_rows<SAMPLE>(U, sconv, task + G, c0, rows);
        __builtin_amdgcn_sched_barrier(0);
#pragma unroll
        for (int k = 0; k < 8; ++k) { const float s1 = wave_sum(acc[k][0] + acc[k][1]), s2 = wave_sum(acc[k][0] * acc[k][0] + acc[k][1] * acc[k][1]); if (lane == 0) { red[w * 16 + 2 * k] = s1; red[w * 16 + 2 * k + 1] = s2; } }
        BSYNC();
        if (tid < 16) { float s = 0.f;
#pragma unroll
            for (int ww = 0; ww < 8; ++ww) s += red[ww * 16 + tid];
            tot[tid] = s; }
        BSYNC();
#pragma unroll
        for (int k = 0; k < 8; ++k) { const float mu = tot[2 * k] * (1.f / 1024.f); const float var = tot[2 * k + 1] * (1.f / 1024.f) - mu * mu; const float rstd = __builtin_amdgcn_rsqf(fmaxf(var, 0.f) + EPS);
            const float y0 = (acc[k][0] - mu) * rstd * g2[0] + b2[0], y1 = (acc[k][1] - mu) * rstd * g2[1] + b2[1];
            *(unsigned*)(OB + (size_t)(urow0 + k) * 2048 + 1024 + c0) = cvt_pk_bf16(fsilu(y0), fsilu(y1)); }
        BSYNC();
    }
}

__device__ __forceinline__ void attn_unit(LAS unsigned char* lds, const bf16* QB, const bf16* KBp, const bf16* VBT, bf16* AO, int unit, int tid) {
    constexpr int KS = 136, VS = 264;
    LAS bf16* Ks = (LAS bf16*)lds;
    LAS bf16* VTs = (LAS bf16*)(lds + 69632);
    const int n = unit >> 6, h = (unit >> 4) & 3, qrow0 = n * 2048 + (unit & 15) * 128;
    const int lane = tid & 63, w = tid >> 6, fr = lane & 15, fq = lane >> 4;
    bf16x8 qf[4]; v4u kreg[8], vreg[8];
    { const bf16* qp = QB + (size_t)(qrow0 + 16 * w + fr) * XDIM + h * 128 + 8 * fq;
#pragma unroll
      for (int ks = 0; ks < 4; ++ks) qf[ks] = *(const bf16x8*)(qp + 32 * ks);
      const int key = tid >> 1, half = tid & 1; const bf16* kp = KBp + ((size_t)(n * 256 + key)) * XDIM + h * 128 + 64 * half;
#pragma unroll
      for (int i = 0; i < 8; ++i) kreg[i] = *(const v4u*)(kp + 8 * i);
#pragma unroll
      for (int i = 0; i < 8; ++i) { const int idx = tid + 512 * i, d = idx >> 5, ch = idx & 31; vreg[i] = *(const v4u*)(VBT + ((size_t)(n * 4 + h) * 128 + d) * 256 + 8 * ch); }
      __builtin_amdgcn_sched_barrier(0);
#pragma unroll
      for (int i = 0; i < 8; ++i) *(LAS v4u*)(Ks + key * KS + 64 * half + 8 * i) = kreg[i];
#pragma unroll
      for (int i = 0; i < 8; ++i) { const int idx = tid + 512 * i, d = idx >> 5, ch = idx & 31; *(LAS v4u*)(VTs + d * VS + 8 * ch) = vreg[i]; } }
    BSYNC();
    f32x4 sc[16]; float rsum[4];
#pragma unroll
    for (int nt = 0; nt < 16; ++nt) { sc[nt] = (f32x4){0.f, 0.f, 0.f, 0.f};
#pragma unroll
        for (int ks = 0; ks < 4; ++ks) { const bf16x8 b = *(const LAS bf16x8*)(Ks + (16 * nt + fr) * KS + 32 * ks + 8 * fq); sc[nt] = __builtin_amdgcn_mfma_f32_16x16x32_bf16(qf[ks], b, sc[nt], 0, 0, 0); } }
#pragma unroll
    for (int r = 0; r < 4; ++r) { float mx = sc[0][r];
#pragma unroll
        for (int nt = 1; nt < 16; ++nt) mx = fmaxf(mx, sc[nt][r]);
        mx = fmaxf(mx, __shfl_xor(mx, 1)); mx = fmaxf(mx, __shfl_xor(mx, 2)); mx = fmaxf(mx, __shfl_xor(mx, 4)); mx = fmaxf(mx, __shfl_xor(mx, 8));
        float s = 0.f;
#pragma unroll
        for (int nt = 0; nt < 16; ++nt) { const float p = fexp(sc[nt][r] - mx); sc[nt][r] = p; s += p; }
        s += __shfl_xor(s, 1); s += __shfl_xor(s, 2); s += __shfl_xor(s, 4); s += __shfl_xor(s, 8); rsum[r] = s; }
    BSYNC();
    LAS bf16* Pw = (LAS bf16*)(lds + w * 8448);
#pragma unroll
    for (int nt = 0; nt < 16; ++nt)
#pragma unroll
        for (int r = 0; r < 4; ++r) Pw[(4 * fq + r) * VS + 16 * nt + fr] = (bf16)f2bf(sc[nt][r]);
    LDS_WAIT(); asm volatile("" ::: "memory");
    f32x4 oc[8];
#pragma unroll
    for (int dt = 0; dt < 8; ++dt) oc[dt] = (f32x4){0.f, 0.f, 0.f, 0.f};
#pragma unroll
    for (int ks = 0; ks < 8; ++ks) { const bf16x8 a = *(const LAS bf16x8*)(Pw + fr * VS + 32 * ks + 8 * fq);
#pragma unroll
        for (int dt = 0; dt < 8; ++dt) { const bf16x8 b = *(const LAS bf16x8*)(VTs + (16 * dt + fr) * VS + 32 * ks + 8 * fq); oc[dt] = __builtin_amdgcn_mfma_f32_16x16x32_bf16(a, b, oc[dt], 0, 0, 0); } }
#pragma unroll
    for (int r = 0; r < 4; ++r) { const float inv = 1.f / rsum[r]; const size_t row = (size_t)(qrow0 + 16 * w + 4 * fq + r);
#pragma unroll
        for (int dt = 0; dt < 8; ++dt) AO[row * XDIM + h * 128 + 16 * dt + fr] = (bf16)f2bf(oc[dt][r] * inv); }
    BSYNC();
}
__device__ __forceinline__ void attn_sample_load_k(const bf16* QB, const float* ck, int s, int tid, f32x4 (&kreg)[4][4], unsigned& qraw) {
    const int n = s >> 2, h = s & 3, qrow0 = MP + n * 8; const int lane = tid & 63, w = __builtin_amdgcn_readfirstlane(tid >> 6);
    const int koff = (tid >> 3) * 512 + 16 * (tid & 7);
#pragma unroll
    for (int p = 0; p < 4; ++p) { const float* kb = ck + (((size_t)n * 256 + 64 * p) * 4 + h) * 128;
#pragma unroll
        for (int i = 0; i < 4; ++i) kreg[p][i] = __builtin_nontemporal_load((const f32x4*)(kb + koff + 4 * i)); }
    qraw = *(const unsigned*)(QB + (size_t)(qrow0 + w) * XDIM + h * 128 + 2 * lane);
}
__device__ __forceinline__ void attn_samples(LAS unsigned char* lds, const bf16* QB, const float* ck, const float* cv, bf16* AO, int first, int last, int G, int tid) {
    if (first >= last) return;
    f32x4 kreg[4][4]; unsigned qraw;
    attn_sample_load_k(QB, ck, first, tid, kreg, qraw);
    for (int s = first; s < last; s += G) {
    typedef float f32x2 __attribute__((ext_vector_type(2)));
    LAS float* Qs = (LAS float*)lds;
    LAS float* Ss = (LAS float*)(lds + 4096);
    LAS float* Pt = (LAS float*)(lds + 12288);
    LAS float* red = (LAS float*)(lds + 20480);
    const int n = s >> 2, h = s & 3, qrow0 = MP + n * 8; const int lane = tid & 63, w = __builtin_amdgcn_readfirstlane(tid >> 6);
    const int key_l = tid >> 3, dseg = tid & 7, d2 = tid & 63, kg = w;
    f32x2 vreg[32];
    __builtin_amdgcn_sched_barrier(0);
    Qs[w * 128 + 2 * lane] = bf2f((bf16)(qraw & 0xffffu)); Qs[w * 128 + 2 * lane + 1] = bf2f((bf16)(qraw >> 16));
    BSYNC();
#pragma unroll
    for (int p = 0; p < 4; ++p) { float a[8];
#pragma unroll
        for (int q = 0; q < 8; ++q) a[q] = 0.f;
#pragma unroll
        for (int i = 0; i < 4; ++i) { const f32x4 kv = kreg[p][i];
#pragma unroll
            for (int q = 0; q < 8; ++q) { const f32x4 qv = *(const LAS f32x4*)(Qs + q * 128 + 16 * dseg + 4 * i); a[q] += (kv[0] * qv[0] + kv[1] * qv[1]) + (kv[2] * qv[2] + kv[3] * qv[3]); } }
        float mine = 0.f;
#pragma unroll
        for (int q = 0; q < 8; ++q) { float v = a[q]; v += __shfl_xor(v, 1); v += __shfl_xor(v, 2); v += __shfl_xor(v, 4); if (dseg == q) mine = v; }
        Ss[dseg * 256 + 64 * p + key_l] = mine; }
    __builtin_amdgcn_sched_barrier(0);
#pragma unroll
    for (int j = 0; j < 32; ++j) { const float* vb = cv + (((size_t)n * 256 + 32 * kg + j) * 4 + h) * 128; vreg[j] = __builtin_nontemporal_load((const f32x2*)(vb + 2 * d2)); }
    if (s + G < last) attn_sample_load_k(QB, ck, s + G, tid, kreg, qraw);
    __builtin_amdgcn_sched_barrier(0);
    BSYNC();
    { const f32x4 sv = *(const LAS f32x4*)(Ss + w * 256 + 4 * lane); float mx = fmaxf(fmaxf(sv[0], sv[1]), fmaxf(sv[2], sv[3]));
#pragma unroll
      for (int o = 1; o < 64; o <<= 1) mx = fmaxf(mx, __shfl_xor(mx, o));
      f32x4 e; e[0] = fexp(sv[0] - mx); e[1] = fexp(sv[1] - mx); e[2] = fexp(sv[2] - mx); e[3] = fexp(sv[3] - mx);
      const float inv = 1.f / wave_sum((e[0] + e[1]) + (e[2] + e[3]));
#pragma unroll
      for (int i = 0; i < 4; ++i) Pt[(4 * lane + i) * 8 + w] = e[i] * inv; }
    BSYNC();
    { f32x2 o[8];
#pragma unroll
      for (int q = 0; q < 8; ++q) o[q] = (f32x2){0.f, 0.f};
#pragma unroll
      for (int j = 0; j < 32; ++j) { const f32x4 p0 = *(const LAS f32x4*)(Pt + (32 * kg + j) * 8), p1 = *(const LAS f32x4*)(Pt + (32 * kg + j) * 8 + 4);
#pragma unroll
          for (int q = 0; q < 4; ++q) { o[q] += vreg[j] * p0[q]; o[q + 4] += vreg[j] * p1[q]; } }
#pragma unroll
      for (int q = 0; q < 8; ++q) *(LAS f32x2*)(red + (kg * 8 + q) * 128 + 2 * d2) = o[q]; }
    BSYNC();
    { const int q = tid >> 6; f32x2 o = (f32x2){0.f, 0.f};
#pragma unroll
      for (int g = 0; g < 8; ++g) o += *(const LAS f32x2*)(red + (g * 8 + q) * 128 + 2 * d2);
      *(unsigned*)(AO + (size_t)(qrow0 + q) * XDIM + h * 128 + 2 * d2) = cvt_pk_bf16(o[0], o[1]); }
    BSYNC();
    }
}

constexpr int I_GU = 32 * 176, I_D = 88 * 64, I_IN = 32 * 192, I_OUT = 32 * 64, I_Q = 32 * 16, I_O = 8 * 64;
static_assert(I_D == I_GU, "items");
constexpr int SEG0 = 2 * I_GU + 2 * I_Q, SEG1 = I_GU + I_IN, SEG2 = I_OUT + I_Q + I_O + I_GU, SEG3 = 2 * I_GU;
__device__ __forceinline__ void convert_items(const Args& args, unsigned char* ws, LAS unsigned char* lds, int seg, int wid, int nw, int wave, int lane) {
    LAS float* scr = (LAS float*)(lds + wave * 16384);
    bf16* Wgu1 = (bf16*)(ws + WS_WGU1); bf16* Wd1 = (bf16*)(ws + WS_WD1); bf16* Win = (bf16*)(ws + WS_WIN); bf16* Wout = (bf16*)(ws + WS_WOUT);
    bf16* Wq = (bf16*)(ws + WS_WQ); bf16* Wkv = (bf16*)(ws + WS_WKV); bf16* Wo = (bf16*)(ws + WS_WO); bf16* Wgu2 = (bf16*)(ws + WS_WGU2); bf16* Wd2 = (bf16*)(ws + WS_WD2);
    const int total = seg == 0 ? SEG0 : (seg == 1 ? SEG1 : (seg == 2 ? SEG2 : SEG3));
    for (int it = wid; it < total; it += nw) {
        int r = it;
        if (seg == 0) {
            if (r < 2 * I_GU) { const int which = r / I_GU; r -= which * I_GU; const int kb = r / 176, nb = r % 176; p0_transpose_item(which == 0 ? args.in[8] : args.in[9], DM, DFF, Wgu1, map_pair(32 * nb, which), scr, 64 * kb, 32 * nb, lane); continue; }
            r -= 2 * I_GU; { const int which = r / I_Q; r -= which * I_Q; const int kb = r / 16, nb = r % 16; p0_transpose_item(which == 0 ? args.in[23] : args.in[24], DM, XDIM, Wkv, which * 512 + 32 * nb, scr, 64 * kb, 32 * nb, lane); }
        } else if (seg == 1) {
            if (r < I_GU) { const int kb = r / 64, nb = r % 64; p0_transpose_item(args.in[10], DFF, DM, Wd1, 32 * nb, scr, 64 * kb, 32 * nb, lane); continue; }
            r -= I_GU; { const int kb = r / 192, nb = r % 192, n0 = 32 * nb; const int dr = n0 < 4096 ? n0 : (n0 < 5120 ? 4096 + map_pair(n0 - 4096, 0) : 4096 + map_pair(n0 - 5120, 1));
                p0_transpose_item(args.in[12], DM, DIN, Win, dr, scr, 64 * kb, n0, lane, args.in[11]); }
        } else if (seg == 2) {
            if (r < I_OUT) { const int kb = r / 64, nb = r % 64; p0_transpose_item(args.in[19], DM, DM, Wout, 32 * nb, scr, 64 * kb, 32 * nb, lane); continue; }
            r -= I_OUT;
            if (r < I_Q) { const int kb = r / 16, nb = r % 16; p0_transpose_item(args.in[22], DM, XDIM, Wq, 32 * nb, scr, 64 * kb, 32 * nb, lane, args.in[20]); continue; }
            r -= I_Q;
            if (r < I_O) { const int kb = r / 64, nb = r % 64; p0_transpose_item(args.in[25], XDIM, DM, Wo, 32 * nb, scr, 64 * kb, 32 * nb, lane); continue; }
            r -= I_O; { const int kb = r / 176, nb = r % 176; p0_transpose_item(args.in[27], DM, DFF, Wgu2, map_pair(32 * nb, 0), scr, 64 * kb, 32 * nb, lane, args.in[26]); }
        } else {
            if (r < I_GU) { const int kb = r / 176, nb = r % 176; p0_transpose_item(args.in[28], DM, DFF, Wgu2, map_pair(32 * nb, 1), scr, 64 * kb, 32 * nb, lane, args.in[26]); continue; }
            r -= I_GU; { const int kb = r / 64, nb = r % 64; p0_transpose_item(args.in[29], DFF, DM, Wd2, 32 * nb, scr, 64 * kb, 32 * nb, lane); }
        }
    }
}
constexpr int N_PHASES = 17;
__global__ void __launch_bounds__(NTHR, 2) mk_fwd(Args args) {
    extern __shared__ __attribute__((aligned(16))) unsigned char lds_raw[];
    LAS unsigned char* lds = (LAS unsigned char*)lds_raw;
    volatile LAS unsigned* MISC = (volatile LAS unsigned*)(lds + MISC_OFF);
    const int tid = threadIdx.x, lane = tid & 63, wave = __builtin_amdgcn_readfirstlane(tid >> 6);
    const int G = gridDim.x, bx = blockIdx.x;
    unsigned char* ws = args.ws; float* out = args.li ? (float*)(ws + 16 * MiB) - O_SHP : args.out;
    unsigned* ctl = (unsigned*)(ws + WS_CTL);
    if (tid < 64) MISC[tid] = 0u;
    __syncthreads();
    XcdBarrier bar; bar.bar = ctl + CW_BAR; bar.x = 0; bar.st = nullptr;
#if !MK_PER_PHASE
    bar = xcd_barrier_post(ctl + CW_BAR, MISC + 8);
#define GRID_BAR() xcd_barrier(bar)
#else
#define GRID_BAR() do {} while (0)
#endif
    const int lo = args.ph_lo, hi = args.ph_hi;
#define IN(k) (lo <= (k) && (k) < hi)
#define SEAM(k) do { if (IN(k) && IN((k) + 1)) GRID_BAR(); } while (0)
    const float* x_prompt = args.in[0]; const float* x_sample = args.in[1]; const float* mem_prompt = args.in[2];
    const float* state_hgrn = args.in[3]; const float* state_conv = args.in[4]; const float* cache_k = args.in[5]; const float* cache_v = args.in[6];
    bf16* Wgu1 = (bf16*)(ws + WS_WGU1); bf16* Wd1 = (bf16*)(ws + WS_WD1); bf16* Win = (bf16*)(ws + WS_WIN); bf16* Wout = (bf16*)(ws + WS_WOUT);
    bf16* Wq = (bf16*)(ws + WS_WQ); bf16* Wkv = (bf16*)(ws + WS_WKV); bf16* Wo = (bf16*)(ws + WS_WO); bf16* Wgu2 = (bf16*)(ws + WS_WGU2); bf16* Wd2 = (bf16*)(ws + WS_WD2);
    bf16* XA = (bf16*)(ws + WS_XA); bf16* MN = (bf16*)(ws + WS_MN); float* X = (float*)(ws + WS_X); bf16* H = (bf16*)(ws + WS_H);
    bf16* QH = (bf16*)(ws + WS_QH); bf16* VH = (bf16*)(ws + WS_VH); bf16* GH = (bf16*)(ws + WS_GH); float* LOGF = (float*)(ws + WS_LOGF);
    float* SS = (float*)(ws + WS_SS); float* U = (float*)(ws + WS_U); bf16* OB = (bf16*)(ws + WS_OB); float* DS = (float*)(ws + WS_DS); bf16* SST = (bf16*)(ws + WS_SST); float* DEC = (float*)(ws + WS_DEC);
    bf16* KB = (bf16*)(ws + WS_KB); bf16* VB = (bf16*)(ws + WS_VB); bf16* QB = (bf16*)(ws + WS_QB); bf16* AO = (bf16*)(ws + WS_AO);
    const int gw = bx * NWAVES + wave, NGW = G * NWAVES;

    if (IN(0)) {
        for (int seg = 0; seg < 4; ++seg) convert_items(args, ws, lds, seg, gw, NGW, wave, lane);
        for (int m = gw; m < MT; m += NGW) { const float* src = m < MP ? x_prompt + (size_t)m * DM : x_sample + (size_t)(m - MP) * DM; rms_row_bf16(src, args.in[7], XA + (size_t)m * DM, X + (size_t)m * DM, lane); }
        for (int m = gw; m < MS; m += NGW) rms_row_bf16(mem_prompt + (size_t)m * DM, args.in[21], MN + (size_t)m * DM, nullptr, lane);
    }
    SEAM(0);
    if (IN(1)) {
        { pg8::Gemm g{XA, Wgu1, MT, 2 * DFF, DM}; pg8::SplitOrder S; S.init(MT, 2 * DFF, G, bx, DM); EpiSwiGLU E{H, DFF, (bf16*)DS, nullptr};
          pg8::gemm_phase<EpiSwiGLU, pg8::SplitOrder, true, true>(lds + RING_OFF, g, S, E); }
    }
    SEAM(1);
    if (IN(2)) { swiglu_fixup((const bf16*)DS, H, nullptr, G, bx * NTHR + tid, G * NTHR); if (hi - lo > 1) GRID_BAR();
        pg8::Gemm g{H, Wd1, MT, DM, DFF}; pg8::SplitOrder S; S.init(MT, DM, G, bx, DFF); EpiResid E{X, DM, 0.5f, DS, XA, SS};
        pg8::gemm_phase<EpiResid, pg8::SplitOrder, true, true>(lds + RING_OFF, g, S, E); }
    SEAM(2);
    if (IN(3)) { resid_fixup<8>(X, XA, SS, DS, DFF, G, gw, NGW, lane); }
    SEAM(3);
    if (IN(4)) { pg8::Gemm g{XA, Win, MT, DIN, DM}; pg8::StaticOrder S; S.init(MT, DIN, G, bx, DM); EpiWin E{QH, VH, GH, LOGF, U, args.in[13], SS};
        pg8::gemm_phase<EpiWin, pg8::StaticOrder, true, true>(lds + RING_OFF, g, S, E);
        { pg8::Gemm g{MN, Wkv, MS, 2 * XDIM, DM}; pg8::StaticOrder S; S.init(MS, 2 * XDIM, G, (bx + G - 96) % G, DM); EpiKV E{out + O_MKP, out + O_MVP, KB, VB};
          pg8::gemm_phase<EpiKV, pg8::StaticOrder, true, true>(lds + RING_OFF, g, S, E); }
    }
    SEAM(4);
    if (IN(5) || IN(17)) { hgrn_chunk_states(lds, LOGF, VH, DS, DEC, bx, 1024, G, tid); }
    if (IN(5) || IN(18)) { hgrn_samples(lds, LOGF, QH, VH, GH, state_hgrn, out + O_SHS, args.in[14], OB, bx, 1024, G, tid); }
    if (IN(5) || IN(19)) {
        conv_tasks<false>(lds, U, state_conv, args.in[15], args.in[16], args.in[17], args.in[18], OB, bx, 1024, G, tid);
        conv_tasks<true>(lds, U, state_conv, args.in[15], args.in[16], args.in[17], args.in[18], OB, 1024 + bx, 1152, G, tid);
        const int gt = bx * NTHR + tid, NGT = G * NTHR;
        for (int i = gt; i < 4 * 30 * 256; i += NGT) { const int n = i / 7680, rem = i % 7680, r = rem >> 8, c4 = rem & 255;
            *(f32x4*)(out + O_SCP + (size_t)i * 4) = *(const f32x4*)(U + ((size_t)(n * 2048 + 2018 + r)) * 1024 + 4 * c4); }
        for (int i0 = gt; i0 < 128 * 30 * 256; i0 += 4 * NGT) { f32x4 t4[4];
#pragma unroll
            for (int k = 0; k < 4; ++k) { const int ii = i0 + k * NGT, i = ii < 128 * 30 * 256 ? ii : gt; const int n = i / 7680, rem = i % 7680, r = rem >> 8, c4 = rem & 255;
                const size_t so = r < 22 ? ((size_t)(n * 30 + 8 + r)) * 1024 + 4 * c4 : ((size_t)(MP + n * 8 + r - 22)) * 1024 + 4 * c4;
                const f32x4 a = __builtin_nontemporal_load((const f32x4*)(state_conv + (r < 22 ? so : 0))), b = *(const f32x4*)(U + (r < 22 ? 0 : so)); t4[k] = r < 22 ? a : b; }
#pragma unroll
            for (int k = 0; k < 4; ++k) { const int ii = i0 + k * NGT; if (ii < 128 * 30 * 256) __builtin_nontemporal_store(t4[k], (f32x4*)(out + O_SCS + (size_t)ii * 4)); } }
    }
    SEAM(5);
    if (IN(6)) {
        const int gt = bx * NTHR + tid, NGT = G * NTHR;
        for (int i = gt; i < 32 * 4096; i += NGT) { const int nh = i >> 12, q4 = i & 4095, d = q4 >> 5, e4 = q4 & 31; f32x4 S = (f32x4){0.f, 0.f, 0.f, 0.f};
#pragma unroll 16
            for (int c = 0; c < 32; ++c) { const size_t task = (size_t)nh * 32 + c; u32x2 w; w.x = cvt_pk_bf16(S[0], S[1]); w.y = cvt_pk_bf16(S[2], S[3]);
                *(u32x2*)(SST + task * 16384 + d * 128 + 4 * e4) = w;
                const f32x4 dc = *(const f32x4*)(DEC + task * 128 + 4 * e4), ds = *(const f32x4*)(DS + task * 16384 + d * 128 + 4 * e4); S = dc * S + ds; }
#pragma unroll
            for (int k = 0; k < 4; ++k) out[O_SHP + (size_t)nh * 16384 + (4 * e4 + k) * 128 + d] = S[k]; }
    }
    SEAM(6);
    if (IN(7)) { hgrn_chunk_outs(lds, LOGF, QH, VH, GH, SST, args.in[14], OB, bx, 1024, G, tid); }
    SEAM(7);
    if (IN(8)) { pg8::Gemm g{OB, Wout, MT, DM, DM}; pg8::SplitOrder S; S.init(MT, DM, G, bx, DM); EpiResid E{X, DM, 1.0f, DS, XA, SS + MT};
        pg8::gemm_phase<EpiResid, pg8::SplitOrder, true, true>(lds + RING_OFF, g, S, E); }
    SEAM(8);
    if (IN(9)) { resid_fixup<8>(X, XA, SS + MT, DS, DM, G, gw, NGW, lane); }
    SEAM(9);
    if (IN(10)) { pg8::Gemm g{XA, Wq, MT, XDIM, DM}; pg8::SplitOrder S; S.init(MT, XDIM, G, bx, DM); EpiResid E{nullptr, 0, 0.08838834764831845f, DS, nullptr, nullptr};
        pg8::gemm_phase<EpiResid, pg8::SplitOrder, true, true>(lds + RING_OFF, g, S, E);
    }
    SEAM(10);
    if (IN(11)) {
        { pg8::SplitOrder S; S.init(MT, XDIM, G, 0, DM);
          const int gt = bx * NTHR + tid, NGT = G * NTHR;
          for (int item = gt; item < S.R * 8192; item += NGT) { const int r = item >> 13, row = (item >> 5) & 255, c8 = item & 31; pg8::Unit u; S.tile_of(S.F * G + r, u);
              float a[8];
#pragma unroll
              for (int i = 0; i < 8; ++i) a[i] = 0.f;
              const bf16* sp = (const bf16*)DS + ((size_t)r * S.ns * 256 + row) * 256 + 8 * c8;
              v4u w3[3];
#pragma unroll
              for (int q = 0; q < 3; ++q) w3[q] = *(const v4u*)(sp + (size_t)(q < S.ns ? q : 0) * 65536);
              for (int q3 = 3; q3 < S.ns; ++q3) { const v4u w = *(const v4u*)(sp + (size_t)q3 * 65536); const unsigned ww[4] = {w.x, w.y, w.z, w.w};
#pragma unroll
                  for (int i = 0; i < 4; ++i) { a[2 * i] += __builtin_bit_cast(float, ww[i] << 16); a[2 * i + 1] += __builtin_bit_cast(float, ww[i] & 0xffff0000u); } }
#pragma unroll
              for (int q = 0; q < 3; ++q) { if (q >= S.ns) continue; const v4u w = w3[q]; const unsigned ww[4] = {w.x, w.y, w.z, w.w};
#pragma unroll
                  for (int i = 0; i < 4; ++i) { a[2 * i] += __builtin_bit_cast(float, ww[i] << 16); a[2 * i + 1] += __builtin_bit_cast(float, ww[i] & 0xffff0000u); } }
              { const float rs = 1.f / sqrtf(SS[MT + u.pm * 256 + row] * (1.f / DM) + EPS);
#pragma unroll
                for (int i = 0; i < 8; ++i) a[i] *= rs; }
              v4u o; o.x = cvt_pk_bf16(a[0], a[1]); o.y = cvt_pk_bf16(a[2], a[3]); o.z = cvt_pk_bf16(a[4], a[5]); o.w = cvt_pk_bf16(a[6], a[7]);
              *(v4u*)(QB + (size_t)(u.pm * 256 + row) * XDIM + u.pn * 256 + 8 * c8) = o; }
          if (hi - lo > 1) GRID_BAR(); }
        for (int u = bx; u < 256; u += G) attn_unit(lds, QB, KB, VB, AO, u, tid);
        attn_samples(lds, QB, cache_k, cache_v, AO, bx, 512, G, tid); }
    SEAM(11);
    if (IN(12)) { pg8::Gemm g{AO, Wo, MT, DM, XDIM}; pg8::SplitOrder S; S.init(MT, DM, G, bx, XDIM); EpiResid E{X, DM, 1.0f, DS, XA, SS + 2 * MT};
        pg8::gemm_phase<EpiResid, pg8::SplitOrder, true, true>(lds + RING_OFF, g, S, E); }
    SEAM(12);
    if (IN(13)) { resid_fixup<2>(X, XA, SS + 2 * MT, DS, XDIM, G, gw, NGW, lane); }
    SEAM(13);
    if (IN(14)) { pg8::Gemm g{XA, Wgu2, MT, 2 * DFF, DM}; pg8::SplitOrder S; S.init(MT, 2 * DFF, G, bx, DM); EpiSwiGLU E{H, DFF, (bf16*)DS, SS + 2 * MT};
        pg8::gemm_phase<EpiSwiGLU, pg8::SplitOrder, true, true>(lds + RING_OFF, g, S, E); }
    SEAM(14);
    if (IN(15)) { swiglu_fixup((const bf16*)DS, H, SS + 2 * MT, G, bx * NTHR + tid, G * NTHR); if (hi - lo > 1) GRID_BAR();
        pg8::Gemm g{H, Wd2, MT, DM, DFF}; pg8::SplitOrder S; S.init(MT, DM, G, bx, DFF); EpiResid E{X, DM, 0.5f, DS, nullptr, nullptr};
        pg8::gemm_phase<EpiResid, pg8::SplitOrder, true, true>(lds + RING_OFF, g, S, E); }
    SEAM(15);
    if (IN(16)) { LAS int* T = (LAS int*)lds; build_split_table(T, G, tid); { f32x4 nx[8];
          if (gw < MT) {
#pragma unroll
              for (int j = 0; j < 8; ++j) nx[j] = ((const f32x4*)(X + (size_t)gw * DM) + lane)[64 * j]; }
          for (int m = gw; m < MT; m += NGW) { f32x4 v[8];
#pragma unroll
              for (int j = 0; j < 8; ++j) v[j] = nx[j];
              if (m + NGW < MT) {
#pragma unroll
                  for (int j = 0; j < 8; ++j) nx[j] = ((const f32x4*)(X + (size_t)(m + NGW) * DM) + lane)[64 * j]; }
              __builtin_amdgcn_sched_barrier(0);
              rms_row_final(v, args.in[30], out + O_Y + (size_t)m * DM, T, DS, 8, m, lane); } } }
#undef IN
#undef SEAM
}

extern "C" void kernel_launch(void* const* d_in, const int* in_sizes, int n_in, void* d_out, int out_size, void* d_ws, size_t ws_size, hipStream_t stream) {
    static int grid = 0;
    if (grid == 0) {
        if (n_in != 31 || (size_t)out_size != O_END || ws_size < WS_END) { fprintf(stderr, "kernel_launch: unexpected sizes n_in %d out %d ws %zu\n", n_in, out_size, ws_size); grid = -1; return; }
        int dev = 0, cus = 0, per_cu = 0;
        if (hipGetDevice(&dev) != hipSuccess || hipDeviceGetAttribute(&cus, hipDeviceAttributeMultiprocessorCount, dev) != hipSuccess) { grid = -1; return; }
        if (hipFuncSetAttribute((const void*)mk_fwd, hipFuncAttributeMaxDynamicSharedMemorySize, LDS_BYTES) != hipSuccess) { fprintf(stderr, "kernel_launch: hipFuncSetAttribute failed\n"); grid = -1; return; }
        if (hipOccupancyMaxActiveBlocksPerMultiprocessor(&per_cu, (const void*)mk_fwd, NTHR, LDS_BYTES) != hipSuccess || per_cu < 1) { fprintf(stderr, "kernel_launch: occupancy query says %d\n", per_cu); (void)hipGetLastError(); grid = -1; return; }
        grid = cus;
    }
    if (grid < 0) return;
    if (hipMemsetAsync((char*)d_ws + WS_CTL, 0, CTL_ZERO_BYTES, stream) != hipSuccess) return;
    Args a{};
    for (int i = 0; i < 31; ++i) a.in[i] = (const float*)d_in[i];
    a.out = (float*)d_out; a.ws = (unsigned char*)d_ws;
#if MK_PER_PHASE
    for (int p = 0; p < N_PHASES; ++p) { a.ph_lo = p; a.ph_hi = p + 1; a.li = p; hipLaunchKernelGGL(mk_fwd, dim3(grid), dim3(NTHR), LDS_BYTES, stream, a); }
#else
    a.ph_lo = 0; a.ph_hi = N_PHASES; a.li = 0;
    hipLaunchKernelGGL(mk_fwd, dim3(grid), dim3(NTHR), LDS_BYTES, stream, a);
#ifdef PROBE_MASK
    for (int p = 0; p < 24; ++p) if ((PROBE_MASK >> p) & 1) { a.ph_lo = p; a.ph_hi = p + 1; a.li = (p == 16) ? 0 : 1; hipLaunchKernelGGL(mk_fwd, dim3(grid), dim3(NTHR), LDS_BYTES, stream, a); }
#endif
#endif
}
```

```cpp
#include <hip/hip_runtime.h>
#include <cstdio>
#include <cstdint>
#ifndef MK_PER_PHASE
#define MK_PER_PHASE 0
#endif
#define GAS __attribute__((address_space(1)))
#define LAS __attribute__((address_space(3)))
typedef unsigned short bf16;
typedef unsigned v4u __attribute__((ext_vector_type(4)));
typedef float f32x4 __attribute__((ext_vector_type(4)));
typedef short bf16x8 __attribute__((ext_vector_type(8)));
typedef GAS unsigned gu32;
typedef GAS unsigned long long gu64;
#define RLX_AGENT __ATOMIC_RELAXED, __HIP_MEMORY_SCOPE_AGENT
#define LDS_WAIT() asm volatile("s_waitcnt lgkmcnt(0)" ::: "memory")
#define VM_WAIT() asm volatile("s_waitcnt vmcnt(0)" ::: "memory")
__device__ __forceinline__ unsigned long long rt() { return __builtin_amdgcn_s_memrealtime(); }
__device__ __forceinline__ unsigned f2bf(float f) { unsigned u = __builtin_bit_cast(unsigned, f); return (u + 0x7fffu + ((u >> 16) & 1u)) >> 16; }
__device__ __forceinline__ unsigned pk2(float lo, float hi) { return f2bf(lo) | (f2bf(hi) << 16); }
namespace pg8 {
#define PG8_LAS __attribute__((address_space(3)))
typedef unsigned short bf16_t;
typedef short bf16x8 __attribute__((ext_vector_type(8)));
typedef float f32x4 __attribute__((ext_vector_type(4)));
typedef unsigned u32x4 __attribute__((ext_vector_type(4)));
constexpr int BM = 256, BK = 64, HALF = 128, HTB = HALF * BK * 2  , STAGE_BYTES = 8 * HTB, NXCD = 8, WGM = 8;

__host__ __device__ __forceinline__ int lds_byte(int r, int c) { const int st = (r >> 4) * 2 + (c >> 5), rr = r & 15, cc = c & 31, ob = rr * 64 + cc * 2; return st * 1024 + (ob ^ (((ob >> 9) & 1) << 5)); }
__host__ __device__ __forceinline__ void stage_rc(int b, int& R, int& C) { const int st = b / 1024, sb = b % 1024, swz = sb ^ (((sb >> 9) & 1) << 5); R = (st >> 1) * 16 + swz / 64; C = (st & 1) * 32 + (swz % 64) / 2; }
__host__ __device__ __forceinline__ int perm32(int rho) { const int n = rho >> 4, i = rho & 15; return 8 * (i >> 2) + 4 * n + (i & 3); }

struct Unit { int pm, pn, k0, nk, split; };
struct Gemm { const bf16_t* A; const bf16_t* Bt; int M, N, K; };

struct StaticOrder {
    int nM, nN, nwg, G, c, ntk;
    __host__ __device__ __forceinline__ void init(int M, int N, int G_, int c_, int K_) { nM = M / BM; nN = N / BM; nwg = nM * nN; G = G_; c = c_; ntk = K_ / BK; }
    __host__ __device__ __forceinline__ void tile_of(int wgid, Unit& u) const { { const int q = nwg / NXCD, r = nwg % NXCD, xcd = wgid % NXCD, off = wgid / NXCD; wgid = (xcd < r ? xcd * (q + 1) : r * (q + 1) + (xcd - r) * q) + off; }
        const int nig = WGM * nN, gid = wgid / nig, fm = gid * WGM, gsz = (nM - fm) < WGM ? (nM - fm) : WGM; u.pm = fm + ((wgid % nig) % gsz); u.pn = (wgid % nig) / gsz; }
    __host__ __device__ __forceinline__ bool next(int i, Unit& u) const {
        const long L = (long)i * G + c; if (L >= nwg) return false;
        int wgid = (int)L; { const int q = nwg / NXCD, r = nwg % NXCD, xcd = wgid % NXCD, off = wgid / NXCD; wgid = (xcd < r ? xcd * (q + 1) : r * (q + 1) + (xcd - r) * q) + off; }
        const int nig = WGM * nN, gid = wgid / nig, fm = gid * WGM, gsz = (nM - fm) < WGM ? (nM - fm) : WGM;
        u.pm = fm + ((wgid % nig) % gsz); u.pn = (wgid % nig) / gsz; u.k0 = 0; u.nk = ntk; u.split = 0; return true;
    }
    __device__ __forceinline__ void a_ready(const Unit&) const {}
    __device__ __forceinline__ void done(const Unit&) const {}
};
struct SplitOrder : StaticOrder {
    int F, R, ns, base, extra, all;
    __host__ __device__ __forceinline__ void init(int M, int N, int G_, int c_, int K_) { StaticOrder::init(M, N, G_, c_, K_); all = 0; F = nwg / G; R = nwg - F * G; ns = 1; base = ntk; extra = 0;
        if (R > 0) { ns = G / R; if (ns > ntk / 4) ns = ntk / 4; if (ns < 1) ns = 1; base = (ntk / (2 * ns)) * 2; extra = (ntk / 2) % ns; } }
    __host__ __device__ __forceinline__ bool next(int i, Unit& u) const {
        if (i < F) { if (i * G + c >= nwg) return false; tile_of(i * G + c, u); u.k0 = 0; u.nk = ntk; u.split = all ? 1 + R * ns + (i * G + c) : 0; return true; }
        if (i > F || c >= R * ns) return false;
        const int sp = c / R; tile_of(F * G + (c % R), u); u.k0 = sp * base + 2 * (sp < extra ? sp : extra); u.nk = base + (sp < extra ? 2 : 0); u.split = ns > 1 ? 1 + (c % R) * ns + sp : 0; return true;
    }
};


__device__ __forceinline__ unsigned cvt_pk_bf16(float lo, float hi) { unsigned r; asm volatile("v_cvt_pk_bf16_f32 %0, %1, %2" : "=v"(r) : "v"(lo), "v"(hi)); return r; }
typedef float f32x2 __attribute__((ext_vector_type(2)));
__device__ __forceinline__ f32x2 gelu_pk(f32x2 v) {
    const f32x2 av = __builtin_elementwise_abs(v), d = av * 0.2316418882f + 1.0f;
    f32x2 t; t.x = __builtin_amdgcn_rcpf(d.x); t.y = __builtin_amdgcn_rcpf(d.y);
    f32x2 q = t * 0.5307027145f + (-0.7265760135f); q = q * t + 0.7107068705f; q = q * t + (-0.142248368f); q = q * t + 0.127414796f; q = q * t;
    const f32x2 s = (v * v) * (-0.72134752044f);
    f32x2 e; e.x = __builtin_amdgcn_exp2f(s.x); e.y = __builtin_amdgcn_exp2f(s.y);
    const f32x2 m = v * (q * e), r = v - m;
    f32x2 o; o.x = v.x < 0.f ? m.x : r.x; o.y = v.y < 0.f ? m.y : r.y; return o;
}

template <int ACT  > struct EpiBf16 {
    static constexpr bool PERM = true, AFTER_DRAIN = false; static_assert(ACT == 0 || ACT == 1, "EpiBf16: ACT is 0 (none) or 1 (gelu_pk)");
    bf16_t* O; int ldc; const float* bias; int split_cols; size_t split_stride; float scale0;
    __device__ __forceinline__ void operator()(const f32x4 (&acc)[2][2][4][2], const Unit& u, int wr, int wc, int fr, int fq) const {
        const int row0 = u.pm * BM + wr * 64 + fr; int colt = u.pn * BM; bf16_t* base = O;
        float sc = 1.f; if (split_cols) { const int t = colt / split_cols; base += (size_t)t * split_stride; colt -= t * split_cols; if (t == 0) sc = scale0; }
        const int col0 = colt + wc * 32 + 8 * fq, bcol0 = u.pn * BM + wc * 32 + 8 * fq;
        f32x4 bv[2][2];
#pragma unroll
        for (int bj = 0; bj < 2; ++bj)
#pragma unroll
            for (int n = 0; n < 2; ++n) bv[bj][n] = bias ? *(const f32x4*)(bias + bcol0 + bj * HALF + 4 * n) : (f32x4){0.f, 0.f, 0.f, 0.f};
#pragma unroll
        for (int ai = 0; ai < 2; ++ai)
#pragma unroll
            for (int m = 0; m < 4; ++m) { bf16_t* rowp = base + (size_t)(row0 + ai * HALF + m * 16) * ldc + col0;
#pragma unroll
                for (int bj = 0; bj < 2; ++bj) { f32x4 v0 = acc[ai][bj][m][0] + bv[bj][0], v1 = acc[ai][bj][m][1] + bv[bj][1];
                    if (ACT == 1) { f32x2 a = gelu_pk((f32x2){v0[0], v0[1]}), b = gelu_pk((f32x2){v0[2], v0[3]}), c = gelu_pk((f32x2){v1[0], v1[1]}), d = gelu_pk((f32x2){v1[2], v1[3]});
                        v0 = (f32x4){a.x, a.y, b.x, b.y}; v1 = (f32x4){c.x, c.y, d.x, d.y}; }
                    v0 = v0 * sc; v1 = v1 * sc; u32x4 w; w.x = cvt_pk_bf16(v0[0], v0[1]); w.y = cvt_pk_bf16(v0[2], v0[3]); w.z = cvt_pk_bf16(v1[0], v1[1]); w.w = cvt_pk_bf16(v1[2], v1[3]);
                    *(u32x4*)(rowp + bj * HALF) = w; } }
    }
};

template <class Epi, class Sched, bool ALIGN_EPI = false, bool SP2 = false>
__device__ __forceinline__ void gemm_phase(PG8_LAS unsigned char* lds, const Gemm g, const Sched& S, const Epi& E) {
    const int tid = threadIdx.x, wid = __builtin_amdgcn_readfirstlane(tid >> 6), lane = tid & 63, wr = wid >> 2, wc = wid & 3, fr = lane & 15, fq = lane >> 4;
    const int K = g.K;
    unsigned voffA[2], voffB[2];
#pragma unroll
    for (int i = 0; i < 2; ++i) { int R, C; stage_rc(tid * 16 + i * 8192, R, C); const int Rb = Epi::PERM ? ((R & ~31) + perm32(R & 31)) : R;
        voffA[i] = (unsigned)(R * K + C) * 2u; voffB[i] = (unsigned)(Rb * K + C) * 2u; }
    const size_t kstep = (size_t)(BK * 2);
    const size_t hstep = (size_t)HALF * K * 2;
    const size_t tstep = 2 * hstep;
    const unsigned ldsw = (unsigned)wid * 1024u;
    const int aoff = lds_byte(wr * 64 + fr, fq * 8), boff = lds_byte(wc * 32 + fr, fq * 8);
#define PG8_SA(b, h) (((b) * 2 + (h)) * HTB)
#define PG8_SB(b, h) ((4 + (b) * 2 + (h)) * HTB)
#define PG8_STAGE(bufoff, gbase, voff) do { _Pragma("unroll") for (int _i = 0; _i < 2; ++_i) \
        __builtin_amdgcn_global_load_lds((const unsigned*)((const char*)(gbase) + (voff)[_i]), (PG8_LAS unsigned*)(lds + (bufoff) + ldsw + _i * 8192), 16, 0, 0); } while (0)
#define PG8_LDA(dst, b, h) do { _Pragma("unroll") for (int m = 0; m < 4; ++m) _Pragma("unroll") for (int k = 0; k < 2; ++k) dst[m][k] = *(const PG8_LAS bf16x8*)(lds + PG8_SA(b, h) + aoff + m * 2048 + k * 1024); } while (0)
#define PG8_LDB(dst, b, h) do { _Pragma("unroll") for (int n = 0; n < 2; ++n) _Pragma("unroll") for (int k = 0; k < 2; ++k) dst[n][k] = *(const PG8_LAS bf16x8*)(lds + PG8_SB(b, h) + boff + n * 2048 + k * 1024); } while (0)
#define PG8_MMA(ai, bj, At, Bt) do { __builtin_amdgcn_s_setprio(1); _Pragma("unroll") for (int m = 0; m < 4; ++m) _Pragma("unroll") for (int n = 0; n < 2; ++n) _Pragma("unroll") for (int k = 0; k < 2; ++k) \
        acc[ai][bj][m][n] = __builtin_amdgcn_mfma_f32_16x16x32_bf16(Bt[n][k], At[m][k], acc[ai][bj][m][n], 0, 0, 0); __builtin_amdgcn_s_setprio(0); } while (0)
#define PG8_WAIT_V(n) asm volatile("s_waitcnt vmcnt(" #n ")" ::: "memory")
#define PG8_WAIT_L(n) asm volatile("s_waitcnt lgkmcnt(" #n ")" ::: "memory")
#define PG8_BAR __builtin_amdgcn_s_barrier()
#define PG8_SCHED __builtin_amdgcn_sched_barrier(0)
    Unit cur, nxt; int ui = 0;
    if (!S.next(0, cur)) return;
    f32x4 acc[2][2][4][2];
#pragma unroll
    for (int a = 0; a < 2; ++a)
#pragma unroll
        for (int b = 0; b < 2; ++b)
#pragma unroll
            for (int m = 0; m < 4; ++m)
#pragma unroll
                for (int n = 0; n < 2; ++n) acc[a][b][m][n] = (f32x4){0.f, 0.f, 0.f, 0.f};
    bf16x8 At[4][2], B0[2][2], B1[2][2];
    const char* cA = (const char*)g.A + (size_t)cur.pm * tstep + (size_t)cur.k0 * kstep; const char* cB = (const char*)g.Bt + (size_t)cur.pn * tstep + (size_t)cur.k0 * kstep;
    S.a_ready(cur);
    if constexpr (SP2) {
        PG8_STAGE(PG8_SB(0, 0), cB, voffB); PG8_STAGE(PG8_SB(0, 1), cB + hstep, voffB); PG8_STAGE(PG8_SA(0, 0), cA, voffA); PG8_STAGE(PG8_SA(0, 1), cA + hstep, voffA);
        if (wr == 1) PG8_BAR;
        PG8_WAIT_V(2); PG8_BAR;
        PG8_STAGE(PG8_SB(1, 0), cB + kstep, voffB); PG8_STAGE(PG8_SA(1, 0), cA + kstep, voffA); PG8_STAGE(PG8_SB(1, 1), cB + hstep + kstep, voffB);
        PG8_WAIT_V(6); PG8_BAR;
    } else {
        PG8_STAGE(PG8_SB(0, 0), cB, voffB); PG8_STAGE(PG8_SA(0, 0), cA, voffA); PG8_STAGE(PG8_SB(0, 1), cB + hstep, voffB); PG8_STAGE(PG8_SA(0, 1), cA + hstep, voffA);
        if (wr == 1) PG8_BAR;
        PG8_WAIT_V(4); PG8_BAR;
        PG8_STAGE(PG8_SB(1, 0), cB + kstep, voffB); PG8_STAGE(PG8_SA(1, 0), cA + kstep, voffA); PG8_STAGE(PG8_SB(1, 1), cB + hstep + kstep, voffB);
        PG8_WAIT_V(6); PG8_BAR;
    }
    for (;;) {
        const bool has_next = S.next(ui + 1, nxt);
        const char* nA = has_next ? (const char*)g.A + (size_t)nxt.pm * tstep + (size_t)nxt.k0 * kstep : cA; const char* nB = has_next ? (const char*)g.Bt + (size_t)nxt.pn * tstep + (size_t)nxt.k0 * kstep : cB;
        const int nt = cur.nk;
        for (int t = 0; t < nt; t += 2) {
            const bool last = (t == nt - 2);
            const char* a1 = cA + (size_t)(t + 1) * kstep;
            const char* a2 = last ? nA : cA + (size_t)(t + 2) * kstep; const char* b2 = last ? nB : cB + (size_t)(t + 2) * kstep;
            const char* a3 = a2 + kstep; const char* b3 = b2 + kstep;
            if (last && has_next) S.a_ready(nxt);
            if constexpr (SP2) {
            PG8_LDB(B0, 0, 0); PG8_LDB(B1, 0, 1); PG8_SCHED; PG8_LDA(At, 0, 0); PG8_STAGE(PG8_SA(1, 1), a1 + hstep, voffA);
            PG8_WAIT_V(8); PG8_WAIT_L(0); PG8_BAR; PG8_MMA(0, 0, At, B0); PG8_MMA(0, 1, At, B1); PG8_BAR; PG8_SCHED;
            PG8_LDA(At, 0, 1); PG8_STAGE(PG8_SB(0, 0), b2, voffB); PG8_STAGE(PG8_SB(0, 1), b2 + hstep, voffB); PG8_STAGE(PG8_SA(0, 0), a2, voffA);
            PG8_WAIT_V(8); PG8_WAIT_L(0); PG8_BAR; PG8_MMA(1, 0, At, B0); PG8_MMA(1, 1, At, B1); PG8_BAR; PG8_SCHED;
            PG8_LDB(B0, 1, 0); PG8_LDB(B1, 1, 1); PG8_SCHED; PG8_LDA(At, 1, 0); PG8_STAGE(PG8_SA(0, 1), a2 + hstep, voffA);
            PG8_WAIT_V(8); PG8_WAIT_L(0); PG8_BAR; PG8_MMA(0, 0, At, B0); PG8_MMA(0, 1, At, B1); PG8_BAR; PG8_SCHED;
            PG8_LDA(At, 1, 1); PG8_STAGE(PG8_SB(1, 0), b3, voffB); PG8_STAGE(PG8_SB(1, 1), b3 + hstep, voffB); PG8_STAGE(PG8_SA(1, 0), a3, voffA);
            PG8_WAIT_V(8); PG8_WAIT_L(0); PG8_BAR; PG8_MMA(1, 0, At, B0); PG8_MMA(1, 1, At, B1); PG8_BAR; PG8_SCHED;
            } else {
            PG8_LDB(B0, 0, 0); PG8_SCHED; PG8_LDA(At, 0, 0); PG8_STAGE(PG8_SA(1, 1), a1 + hstep, voffA);
            PG8_WAIT_L(8); PG8_BAR; PG8_WAIT_L(0); PG8_MMA(0, 0, At, B0); PG8_BAR; PG8_SCHED;
            PG8_LDB(B1, 0, 1); PG8_STAGE(PG8_SB(0, 0), b2, voffB);
            PG8_BAR; PG8_WAIT_L(0); PG8_MMA(0, 1, At, B1); PG8_BAR;
            PG8_LDA(At, 0, 1); PG8_STAGE(PG8_SA(0, 0), a2, voffA);
            PG8_BAR; PG8_WAIT_L(0); PG8_MMA(1, 0, At, B0); PG8_BAR; PG8_SCHED;
            PG8_STAGE(PG8_SB(0, 1), b2 + hstep, voffB);
            PG8_WAIT_V(6); PG8_BAR; PG8_MMA(1, 1, At, B1); PG8_BAR;
            PG8_LDB(B0, 1, 0); PG8_SCHED; PG8_LDA(At, 1, 0); PG8_STAGE(PG8_SA(0, 1), a2 + hstep, voffA);
            PG8_WAIT_L(8); PG8_BAR; PG8_WAIT_L(0); PG8_MMA(0, 0, At, B0); PG8_BAR; PG8_SCHED;
            PG8_LDB(B1, 1, 1); PG8_STAGE(PG8_SB(1, 0), b3, voffB);
            PG8_BAR; PG8_WAIT_L(0); PG8_MMA(0, 1, At, B1); PG8_BAR;
            PG8_LDA(At, 1, 1); PG8_STAGE(PG8_SA(1, 0), a3, voffA);
            PG8_BAR; PG8_WAIT_L(0); PG8_MMA(1, 0, At, B0); PG8_BAR; PG8_SCHED;
            PG8_STAGE(PG8_SB(1, 1), b3 + hstep, voffB);
            PG8_WAIT_V(6); PG8_BAR; PG8_MMA(1, 1, At, B1); PG8_BAR;
            }
        }
        if constexpr (ALIGN_EPI) { if (wr == 0) PG8_BAR; }
        if constexpr (!Epi::AFTER_DRAIN) { E(acc, cur, wr, wc, fr, fq); S.done(cur); }
        if (!has_next) break;
#pragma unroll
        for (int a = 0; a < 2; ++a)
#pragma unroll
            for (int b = 0; b < 2; ++b)
#pragma unroll
                for (int m = 0; m < 4; ++m)
#pragma unroll
                    for (int n = 0; n < 2; ++n) acc[a][b][m][n] = (f32x4){0.f, 0.f, 0.f, 0.f};
        cur = nxt; cA = nA; cB = nB; ++ui;
        if constexpr (ALIGN_EPI) { if (wr == 1) PG8_BAR; }
    }
    PG8_WAIT_V(0);
    if constexpr (!ALIGN_EPI) { if (wr == 0) PG8_BAR; }
    PG8_BAR;
    if constexpr (Epi::AFTER_DRAIN) { E.fused(acc, cur, wr, wc, fr, fq, lds, wid, lane); S.done(cur); }
#undef PG8_SA
#undef PG8_SB
#undef PG8_STAGE
#undef PG8_LDA
#undef PG8_LDB
#undef PG8_MMA
#undef PG8_WAIT_V
#undef PG8_WAIT_L
#undef PG8_BAR
#undef PG8_SCHED
}
}
#define XB_TMO      128
#define XB_XCNT(j)  (256  + 64 * (j))
#define XB_XSUB(j)  (1280 + 64 * (j))
#define XB_XGEN(j)  (2304 + 64 * (j))
#define XB_TOP      3328
#define XB_TOPGEN   3392
#define XCD_BAR_WORDS 3456
#define XB_SPIN_CAP (1u << 18)

__device__ __forceinline__ unsigned xb_ld(unsigned* p)              { return __hip_atomic_load(p, __ATOMIC_RELAXED, __HIP_MEMORY_SCOPE_AGENT); }
__device__ __forceinline__ unsigned xb_add(unsigned* p, unsigned v) { return __hip_atomic_fetch_add(p, v, __ATOMIC_RELAXED, __HIP_MEMORY_SCOPE_AGENT); }
__device__ __forceinline__ unsigned xb_xcc_id() { return (unsigned)__builtin_amdgcn_s_getreg((3 << 11) | 20) & 0xFu; }
#define XB_SPIN(cond, bar) do { unsigned _sp = 0; while (cond) { __builtin_amdgcn_s_sleep(1); \
    if ((++_sp & 255u) == 0u) { if (xb_ld(&(bar)[XB_TMO])) break; if (_sp > XB_SPIN_CAP) { atomicAdd(&(bar)[XB_TMO], 1u); break; } } } } while (0)

struct XcdBarrier {
    unsigned* bar; unsigned x;
    volatile LAS unsigned* st;
};

__device__ __forceinline__ XcdBarrier xcd_barrier_post(unsigned* bar, volatile LAS unsigned* st) {
    XcdBarrier b; b.bar = bar; b.x = xb_xcc_id(); b.st = st;
    if (threadIdx.x == 0) (void)xb_add(&bar[XB_XCNT(b.x)], 1u);
    return b;
}
__device__ __forceinline__ void xcd_barrier_complete(unsigned* bar, unsigned x, unsigned& nloc, unsigned& nx) {
    const unsigned G = gridDim.x * gridDim.y * gridDim.z;
    unsigned sum, cnt, mine, sp = 0u;
    for (;;) {
        sum = 0u; cnt = 0u; mine = 0u;
#pragma unroll
        for (unsigned j = 0; j < 16; ++j) { const unsigned c = xb_ld(&bar[XB_XCNT(j)]); sum += c; cnt += (c > 0u) ? 1u : 0u; mine = (j == x) ? c : mine; }
        if (sum == G) break;
        __builtin_amdgcn_s_sleep(1);
        if ((++sp & 255u) == 0u) { if (xb_ld(&bar[XB_TMO])) break; if (sp > XB_SPIN_CAP) { atomicAdd(&bar[XB_TMO], 1u); break; } }
    }
    nloc = mine > 0u ? mine : 1u; nx = cnt > 0u ? cnt : 1u;
}

__device__ __forceinline__ void xcd_barrier(const XcdBarrier& b) {
    asm volatile("s_waitcnt vmcnt(0)" ::: "memory");
    __syncthreads();
    if (threadIdx.x == 0) {
        unsigned* bar = b.bar;
        __builtin_amdgcn_s_waitcnt(0);
        unsigned nloc = b.st[0], nx = b.st[1];
        if (nloc == 0u) { xcd_barrier_complete(bar, b.x, nloc, nx); b.st[0] = nloc; b.st[1] = nx; }
        const unsigned old = xb_add(&bar[XB_XSUB(b.x)], 1u);
        const unsigned gen = old / nloc;
        if (old + 1u == (gen + 1u) * nloc) {
            __builtin_amdgcn_fence(__ATOMIC_RELEASE, "agent");
            asm volatile("s_waitcnt vmcnt(0)" ::: "memory");
            const unsigned og = xb_add(&bar[XB_TOP], 1u);
            const unsigned tg = og / nx;
            if (og + 1u == (tg + 1u) * nx) xb_add(&bar[XB_TOPGEN], 1u);
            else XB_SPIN(xb_ld(&bar[XB_TOPGEN]) == tg, bar);
            __builtin_amdgcn_fence(__ATOMIC_ACQUIRE, "agent");
            xb_add(&bar[XB_XGEN(b.x)], 1u);
            asm volatile("s_waitcnt vmcnt(0)" ::: "memory");
        } else {
            XB_SPIN(xb_ld(&bar[XB_XGEN(b.x)]) == gen, bar);
            __builtin_amdgcn_fence(__ATOMIC_ACQUIRE, "agent");
            asm volatile("s_waitcnt vmcnt(0)" ::: "memory");
        }
    }
    __syncthreads();
}

constexpr int NWAVES = 8, NTHR = 512;
constexpr int DM = 2048, MP = 8192, MS = 1024, MT = MP + MS;
constexpr int DFF = 5632, DIN = 6144, NH = 8, HE = 128, HV = 128, CC = 1024, CW = 31, MEML = 256, XH = 4, XD = 128, XDIM = 512;
constexpr float EPS = 1e-6f;
constexpr size_t O_Y = 0, O_SHP = 18874368, O_SCP = 19398656, O_MKP = 19521536, O_MVP = 20045824, O_SHS = 20570112, O_SCS = 37347328, O_END = 41279488;
constexpr size_t MiB = 1u << 20;
constexpr size_t WS_CTL = 0, CTL_ZERO_BYTES = 1 * MiB;
constexpr size_t WS_WGU1 = 2 * MiB, WS_WD1 = 46 * MiB, WS_WIN = 68 * MiB, WS_WOUT = 92 * MiB, WS_WQ = 100 * MiB, WS_WKV = 102 * MiB, WS_WO = 106 * MiB, WS_WGU2 = 108 * MiB, WS_WD2 = 152 * MiB;
constexpr size_t WS_XA = 174 * MiB, WS_MN = 210 * MiB, WS_X = 214 * MiB, WS_H = 286 * MiB;
constexpr size_t WS_QH = WS_H, WS_VH = WS_H + 18 * MiB, WS_GH = WS_H + 36 * MiB, WS_LOGF = WS_H + 54 * MiB;
constexpr size_t WS_U = 385 * MiB, WS_OB = 421 * MiB, WS_DS = 457 * MiB, WS_SST = 521 * MiB, WS_DEC = 553 * MiB, WS_KB = 554 * MiB, WS_VB = 555 * MiB, WS_QB = 556 * MiB, WS_AO = 565 * MiB, WS_END = 574 * MiB;
constexpr int CW_BAR = 4096;
constexpr size_t WS_SS = 65536;
constexpr int RING_OFF = 0, LDS_BYTES = 147456, MISC_OFF = LDS_BYTES - 256;

typedef unsigned u32x2 __attribute__((ext_vector_type(2)));
__device__ __forceinline__ float bf2f(unsigned short h) { return __builtin_bit_cast(float, (unsigned)h << 16); }
__device__ __forceinline__ float fexp(float x) { return __builtin_amdgcn_exp2f(x * 1.4426950408889634f); }
__device__ __forceinline__ float fsigmoid(float x) { return __builtin_amdgcn_rcpf(1.f + fexp(-x)); }
__device__ __forceinline__ float fsilu(float x) { return x * fsigmoid(x); }
__device__ __forceinline__ float wave_sum(float v) {
#pragma unroll
    for (int o = 1; o < 64; o <<= 1) v += __shfl_xor(v, o);
    return v;
}
using pg8::cvt_pk_bf16;

struct EpiSwiGLU {
    static constexpr bool PERM = true, AFTER_DRAIN = false;
    bf16* H; int ldh; bf16* slab; const float* ss;
    __device__ __forceinline__ void operator()(const f32x4 (&acc)[2][2][4][2], const pg8::Unit& u, int wr, int wc, int fr, int fq) const {
        if (u.split) {
            bf16* sb = slab + (size_t)(u.split - 1) * 65536 + (size_t)(wr * 64 + fr) * 256 + wc * 32 + 8 * fq;
#pragma unroll
            for (int ai = 0; ai < 2; ++ai)
#pragma unroll
                for (int m = 0; m < 4; ++m)
#pragma unroll
                    for (int bj = 0; bj < 2; ++bj) { const f32x4 v0 = acc[ai][bj][m][0], v1 = acc[ai][bj][m][1]; v4u w;
                        w.x = cvt_pk_bf16(v0[0], v0[1]); w.y = cvt_pk_bf16(v0[2], v0[3]); w.z = cvt_pk_bf16(v1[0], v1[1]); w.w = cvt_pk_bf16(v1[2], v1[3]);
                        *(v4u*)(sb + (ai * 128 + m * 16) * 256 + bj * 128) = w; }
            return;
        }
        const int row0 = u.pm * 256 + wr * 64 + fr, col0 = u.pn * 128 + wc * 32 + 8 * fq;
        float sq[2][4];
#pragma unroll
        for (int ai = 0; ai < 2; ++ai)
#pragma unroll
            for (int m = 0; m < 4; ++m) sq[ai][m] = ss ? ss[row0 + ai * 128 + m * 16] : 0.f;
#pragma unroll
        for (int ai = 0; ai < 2; ++ai)
#pragma unroll
            for (int m = 0; m < 4; ++m) {
                bf16* rowp = H + (size_t)(row0 + ai * 128 + m * 16) * ldh + col0;
                const float rs = ss ? __builtin_amdgcn_rsqf(sq[ai][m] * (1.f / DM) + EPS) : 1.f;
                const f32x4 g0 = acc[ai][0][m][0] * rs, g1 = acc[ai][0][m][1] * rs, u0 = acc[ai][1][m][0] * rs, u1 = acc[ai][1][m][1] * rs;
                v4u w;
                w.x = cvt_pk_bf16(fsilu(g0[0]) * u0[0], fsilu(g0[1]) * u0[1]); w.y = cvt_pk_bf16(fsilu(g0[2]) * u0[2], fsilu(g0[3]) * u0[3]);
                w.z = cvt_pk_bf16(fsilu(g1[0]) * u1[0], fsilu(g1[1]) * u1[1]); w.w = cvt_pk_bf16(fsilu(g1[2]) * u1[2], fsilu(g1[3]) * u1[3]);
                *(v4u*)rowp = w;
            }
    }
};
__device__ __forceinline__ void swiglu_fixup(const bf16* slab, bf16* H, const float* ss, int G, int gt, int NGT) {
    pg8::SplitOrder S; S.init(MT, 2 * DFF, G, 0, DM);
    if (S.R == 0 || S.ns <= 1) return;
    for (int item = gt; item < S.R * 4096; item += NGT) { const int r = item >> 12, row = (item >> 4) & 255, c8 = item & 15; pg8::Unit u; S.tile_of(S.F * G + r, u);
        float g[8], up[8];
#pragma unroll
        for (int i = 0; i < 8; ++i) { g[i] = 0.f; up[i] = 0.f; }
        const bf16* sp = slab + ((size_t)r * S.ns * 256 + row) * 256 + 8 * c8;
        v4u a5[5], b5[5];
#pragma unroll
        for (int q = 0; q < 5; ++q) { const size_t qo = (size_t)(q < S.ns ? q : 0) * 65536; a5[q] = *(const v4u*)(sp + qo); b5[q] = *(const v4u*)(sp + qo + 128); }
        for (int q5 = 5; q5 < S.ns; ++q5) { const v4u a = *(const v4u*)(sp + (size_t)q5 * 65536), b = *(const v4u*)(sp + (size_t)q5 * 65536 + 128); const unsigned aw[4] = {a.x, a.y, a.z, a.w}, bw[4] = {b.x, b.y, b.z, b.w};
#pragma unroll
            for (int i = 0; i < 4; ++i) { g[2 * i] += __builtin_bit_cast(float, aw[i] << 16); g[2 * i + 1] += __builtin_bit_cast(float, aw[i] & 0xffff0000u);
                up[2 * i] += __builtin_bit_cast(float, bw[i] << 16); up[2 * i + 1] += __builtin_bit_cast(float, bw[i] & 0xffff0000u); } }
#pragma unroll
        for (int q = 0; q < 5; ++q) { if (q >= S.ns) continue; const v4u a = a5[q], b = b5[q];
            const unsigned aw[4] = {a.x, a.y, a.z, a.w}, bw[4] = {b.x, b.y, b.z, b.w};
#pragma unroll
            for (int i = 0; i < 4; ++i) { g[2 * i] += __builtin_bit_cast(float, aw[i] << 16); g[2 * i + 1] += __builtin_bit_cast(float, aw[i] & 0xffff0000u);
                up[2 * i] += __builtin_bit_cast(float, bw[i] << 16); up[2 * i + 1] += __builtin_bit_cast(float, bw[i] & 0xffff0000u); } }
        if (ss) { const float rs = 1.f / sqrtf(ss[u.pm * 256 + row] * (1.f / DM) + EPS);
#pragma unroll
            for (int i = 0; i < 8; ++i) { g[i] *= rs; up[i] *= rs; } }
        v4u w; w.x = cvt_pk_bf16(fsilu(g[0]) * up[0], fsilu(g[1]) * up[1]); w.y = cvt_pk_bf16(fsilu(g[2]) * up[2], fsilu(g[3]) * up[3]);
        w.z = cvt_pk_bf16(fsilu(g[4]) * up[4], fsilu(g[5]) * up[5]); w.w = cvt_pk_bf16(fsilu(g[6]) * up[6], fsilu(g[7]) * up[7]);
        *(v4u*)(H + (size_t)(u.pm * 256 + row) * DFF + u.pn * 128 + 8 * c8) = w; }
}
struct EpiResid {
    static constexpr bool PERM = false, AFTER_DRAIN = false;
    float* X; int ldc; float scale; float* slab; bf16* XAo; float* ss;
    __device__ __forceinline__ void operator()(const f32x4 (&acc)[2][2][4][2], const pg8::Unit& u, int wr, int wc, int fr, int fq) const {
        const int rl = wr * 64 + fr, cl = wc * 32 + 4 * fq;
        if (u.split) {
            bf16* sb = (bf16*)slab + (size_t)(u.split - 1) * 65536 + (size_t)rl * 256 + cl;
#pragma unroll
            for (int ai = 0; ai < 2; ++ai)
#pragma unroll
                for (int m = 0; m < 4; ++m)
#pragma unroll
                    for (int bj = 0; bj < 2; ++bj)
#pragma unroll
                        for (int n = 0; n < 2; ++n) { const f32x4 v = acc[ai][bj][m][n] * scale; u32x2 w; w.x = cvt_pk_bf16(v[0], v[1]); w.y = cvt_pk_bf16(v[2], v[3]);
                            *(u32x2*)(sb + (ai * 128 + m * 16) * 256 + bj * 128 + n * 16) = w; }
        } else {
#pragma unroll
            for (int ai = 0; ai < 2; ++ai)
#pragma unroll
                for (int m = 0; m < 4; ++m) {
                    const size_t ro = (size_t)(u.pm * 256 + rl + ai * 128 + m * 16) * ldc + u.pn * 256 + cl; float* rowp = X + ro; float s2 = 0.f;
#pragma unroll
                    for (int bj = 0; bj < 2; ++bj)
#pragma unroll
                        for (int n = 0; n < 2; ++n) { f32x4* p = (f32x4*)(rowp + bj * 128 + n * 16); const f32x4 v = *p + acc[ai][bj][m][n] * scale; *p = v;
                            if (XAo) { u32x2 w; w.x = cvt_pk_bf16(v[0], v[1]); w.y = cvt_pk_bf16(v[2], v[3]); *(u32x2*)(XAo + ro + bj * 128 + n * 16) = w; s2 += (v[0] * v[0] + v[1] * v[1]) + (v[2] * v[2] + v[3] * v[3]); } }
                    if (XAo) { s2 += __shfl_xor(s2, 16); s2 += __shfl_xor(s2, 32); if (fq == 0) __hip_atomic_fetch_add(ss + (u.pm * 256 + rl + ai * 128 + m * 16), s2, __ATOMIC_RELAXED, __HIP_MEMORY_SCOPE_AGENT); }
                }
        }
    }
};
struct EpiKV {
    static constexpr bool PERM = false, AFTER_DRAIN = false;
    float* outK; float* outV; bf16* KB; bf16* VBT;
    __device__ __forceinline__ void operator()(const f32x4 (&acc)[2][2][4][2], const pg8::Unit& u, int wr, int wc, int fr, int fq) const {
        const int row0 = u.pm * 256 + wr * 64 + fr; const bool isv = u.pn >= 2; const int col0 = (u.pn & 1) * 256 + wc * 32 + 4 * fq;
        float* of = isv ? outV : outK;
#pragma unroll
        for (int ai = 0; ai < 2; ++ai)
#pragma unroll
            for (int m = 0; m < 4; ++m) {
                const int row = row0 + ai * 128 + m * 16; const size_t ro = (size_t)row * XDIM + col0;
#pragma unroll
                for (int bj = 0; bj < 2; ++bj)
#pragma unroll
                    for (int n = 0; n < 2; ++n) { const f32x4 v = acc[ai][bj][m][n]; *(f32x4*)(of + ro + bj * 128 + n * 16) = v;
                        if (!isv) { u32x2 w; w.x = cvt_pk_bf16(v[0], v[1]); w.y = cvt_pk_bf16(v[2], v[3]); *(u32x2*)(KB + ro + bj * 128 + n * 16) = w; }
                        else { const int col = col0 + bj * 128 + n * 16; bf16* vt = VBT + ((size_t)(row >> 8) * 512 + col) * 256 + (row & 255);
#pragma unroll
                            for (int i = 0; i < 4; ++i) vt[i * 256] = (bf16)f2bf(v[i]); } }
            }
    }
};
struct EpiWin {
    static constexpr bool PERM = true, AFTER_DRAIN = false;
    bf16* QH; bf16* VH; bf16* GH; float* LOGF; float* U; const float* lbp; const float* ss;
    __device__ __forceinline__ void operator()(const f32x4 (&acc)[2][2][4][2], const pg8::Unit& u, int wr, int wc, int fr, int fq) const {
        const int row0 = u.pm * 256 + wr * 64 + fr; const int ty = u.pn >> 2;
        float sq[2][4];
#pragma unroll
        for (int ai = 0; ai < 2; ++ai)
#pragma unroll
            for (int m = 0; m < 4; ++m) sq[ai][m] = ss[row0 + ai * 128 + m * 16];
        if (ty == 0 || ty == 2 || ty == 3) {
            bf16* dst = QH + (size_t)(ty == 0 ? 0 : ty - 1) * (size_t)(9u << 20); const int col0 = (u.pn & 3) * 256 + wc * 32 + 8 * fq;
#pragma unroll
            for (int ai = 0; ai < 2; ++ai)
#pragma unroll
                for (int m = 0; m < 4; ++m) { const float rs = __builtin_amdgcn_rsqf(sq[ai][m] * (1.f / DM) + EPS); bf16* rowp = dst + (size_t)(row0 + ai * 128 + m * 16) * 1024 + col0;
#pragma unroll
                    for (int bj = 0; bj < 2; ++bj) { f32x4 v0 = acc[ai][bj][m][0] * rs, v1 = acc[ai][bj][m][1] * rs;
                        if (ty != 2) {
#pragma unroll
                            for (int i = 0; i < 4; ++i) { v0[i] = fsilu(v0[i]); v1[i] = fsilu(v1[i]); } }
                        v4u w; w.x = cvt_pk_bf16(v0[0], v0[1]); w.y = cvt_pk_bf16(v0[2], v0[3]); w.z = cvt_pk_bf16(v1[0], v1[1]); w.w = cvt_pk_bf16(v1[2], v1[3]);
                        *(v4u*)(rowp + bj * 128) = w; } }
        } else if (ty == 1) {
            const int col0 = (u.pn & 3) * 256 + wc * 32 + 8 * fq;
            f32x4 lb[2][2];
#pragma unroll
            for (int bj = 0; bj < 2; ++bj)
#pragma unroll
                for (int n = 0; n < 2; ++n) { const f32x4 a0 = *(const f32x4*)(lbp + col0 + bj * 128 + 4 * n), a1 = *(const f32x4*)(lbp + 1024 + col0 + bj * 128 + 4 * n);
#pragma unroll
                    for (int i = 0; i < 4; ++i) lb[bj][n][i] = fsigmoid(a0[i] - a1[i]); }
#pragma unroll
            for (int ai = 0; ai < 2; ++ai)
#pragma unroll
                for (int m = 0; m < 4; ++m) { const float rs = __builtin_amdgcn_rsqf(sq[ai][m] * (1.f / DM) + EPS); float* rowp = LOGF + (size_t)(row0 + ai * 128 + m * 16) * 1024 + col0;
#pragma unroll
                    for (int bj = 0; bj < 2; ++bj)
#pragma unroll
                        for (int n = 0; n < 2; ++n) { const f32x4 z = acc[ai][bj][m][n] * rs; f32x4 o;
#pragma unroll
                            for (int i = 0; i < 4; ++i) { const float l = lb[bj][n][i]; o[i] = __logf(l + (1.f - l) * fsigmoid(z[i])); }
                            *(f32x4*)(rowp + bj * 128 + 4 * n) = o; } }
        } else {
            const int col0 = (u.pn - 16) * 128 + wc * 32 + 8 * fq;
#pragma unroll
            for (int ai = 0; ai < 2; ++ai)
#pragma unroll
                for (int m = 0; m < 4; ++m) { const float rs = __builtin_amdgcn_rsqf(sq[ai][m] * (1.f / DM) + EPS); float* rowp = U + (size_t)(row0 + ai * 128 + m * 16) * 1024 + col0;
#pragma unroll
                    for (int n = 0; n < 2; ++n) { const f32x4 a = acc[ai][0][m][n] * rs, b = acc[ai][1][m][n] * rs; f32x4 o;
#pragma unroll
                        for (int i = 0; i < 4; ++i) o[i] = a[i] * fsigmoid(b[i]);
                        *(f32x4*)(rowp + 4 * n) = o; } }
        }
    }
};

__device__ __forceinline__ void p0_transpose_item(const float* W, int K, int N, bf16* WT, int dst_row0, LAS float* scr, int k0, int n0, int lane, const float* gain = nullptr) {
#pragma unroll 8
    for (int i = 0; i < 32; ++i) { const int kk = 2 * i + (lane >> 5); scr[kk * 33 + (lane & 31)] = __builtin_nontemporal_load(W + (size_t)(k0 + kk) * N + n0 + (lane & 31)); }
    LDS_WAIT(); asm volatile("" ::: "memory");
    const int c = lane & 7;
    f32x4 g0 = (f32x4){1.f, 1.f, 1.f, 1.f}, g1 = g0; if (gain) { g0 = *(const f32x4*)(gain + k0 + 8 * c); g1 = *(const f32x4*)(gain + k0 + 8 * c + 4); }
#pragma unroll
    for (int j = 0; j < 4; ++j) { const int n = (lane >> 3) + 8 * j; const LAS float* s = scr + (8 * c) * 33 + n;
        v4u o; o.x = pk2(s[0 * 33] * g0[0], s[1 * 33] * g0[1]); o.y = pk2(s[2 * 33] * g0[2], s[3 * 33] * g0[3]); o.z = pk2(s[4 * 33] * g1[0], s[5 * 33] * g1[1]); o.w = pk2(s[6 * 33] * g1[2], s[7 * 33] * g1[3]);
        *(v4u*)(WT + (size_t)(dst_row0 + n) * K + k0 + 8 * c) = o; }
    LDS_WAIT(); asm volatile("" ::: "memory");
}
__device__ __forceinline__ int map_pair(int n0, int second) { return 256 * (n0 >> 7) + 128 * second + (n0 & 127); }
__device__ __forceinline__ void rms_row_bf16(const float* xrow, const float* g, bf16* orow, float* copy, int lane) {
    const f32x4* xr = (const f32x4*)xrow + lane; f32x4 v[8]; float s = 0.f;
#pragma unroll
    for (int j = 0; j < 8; ++j) { v[j] = xr[64 * j]; s += (v[j][0] * v[j][0] + v[j][1] * v[j][1]) + (v[j][2] * v[j][2] + v[j][3] * v[j][3]); }
    if (copy) {
#pragma unroll
        for (int j = 0; j < 8; ++j) ((f32x4*)copy + lane)[64 * j] = v[j]; }
    const float r = 1.f / sqrtf(wave_sum(s) * (1.f / DM) + EPS);
    u32x2* o8 = (u32x2*)orow + lane;
#pragma unroll
    for (int j = 0; j < 8; ++j) { const f32x4 gg = ((const f32x4*)g + lane)[64 * j]; u32x2 w; w.x = cvt_pk_bf16(v[j][0] * r * gg[0], v[j][1] * r * gg[1]); w.y = cvt_pk_bf16(v[j][2] * r * gg[2], v[j][3] * r * gg[3]); o8[64 * j] = w; }
}
__device__ __forceinline__ void build_split_table(LAS int* T, int G, int tid) {
    pg8::SplitOrder S; S.init(MT, DM, G, 0, DM);
    for (int i = tid; i < 36 * 8; i += NTHR) T[i] = -1;
    __syncthreads();
    if (tid < S.R) { pg8::Unit u; S.tile_of(S.F * G + tid, u); T[u.pm * 8 + u.pn] = tid; }
    __syncthreads();
}
__device__ __forceinline__ void build_slab_table_all(LAS int* T, int G, int tid) {
    pg8::SplitOrder S; S.init(MT, DM, G, 0, XDIM);
    for (int L = tid; L < S.nwg; L += NTHR) { pg8::Unit u; S.tile_of(L, u); const bool rem = L >= S.F * G; T[u.pm * 8 + u.pn] = rem ? (L - S.F * G) * S.ns : S.R * S.ns + L; T[288 + u.pm * 8 + u.pn] = rem ? S.ns : 1; }
    __syncthreads();
}
template <int MAXNS>
__device__ __forceinline__ void resid_fixup(float* X, bf16* XAo, float* ss, const float* slab, int K, int G, int gw, int NGW, int lane) {
    pg8::SplitOrder S; S.init(MT, DM, G, 0, K);
    for (int item = gw; item < S.R * 256; item += NGW) { const int r = item >> 8, rr = item & 255; pg8::Unit u; S.tile_of(S.F * G + r, u);
        const size_t ro = (size_t)(u.pm * 256 + rr) * DM + u.pn * 256 + 4 * lane; f32x4 v = *(const f32x4*)(X + ro);
        const bf16* sp = (const bf16*)slab + ((size_t)r * S.ns * 256 + rr) * 256 + 4 * lane;
        u32x2 wq[MAXNS];
#pragma unroll
        for (int q = 0; q < MAXNS; ++q) wq[q] = *(const u32x2*)(sp + (size_t)(q < S.ns ? q : 0) * 65536);
        for (int q = MAXNS; q < S.ns; ++q) { const u32x2 w = *(const u32x2*)(sp + (size_t)q * 65536);
            v[0] += __builtin_bit_cast(float, w.x << 16); v[1] += __builtin_bit_cast(float, w.x & 0xffff0000u); v[2] += __builtin_bit_cast(float, w.y << 16); v[3] += __builtin_bit_cast(float, w.y & 0xffff0000u); }
#pragma unroll
        for (int q = 0; q < MAXNS; ++q) { if (q >= S.ns) continue; const u32x2 w = wq[q];
            v[0] += __builtin_bit_cast(float, w.x << 16); v[1] += __builtin_bit_cast(float, w.x & 0xffff0000u); v[2] += __builtin_bit_cast(float, w.y << 16); v[3] += __builtin_bit_cast(float, w.y & 0xffff0000u); }
        *(f32x4*)(X + ro) = v; u32x2 w; w.x = cvt_pk_bf16(v[0], v[1]); w.y = cvt_pk_bf16(v[2], v[3]); *(u32x2*)(XAo + ro) = w;
        const float s2 = wave_sum((v[0] * v[0] + v[1] * v[1]) + (v[2] * v[2] + v[3] * v[3])); if (lane == 0) __hip_atomic_fetch_add(ss + (u.pm * 256 + rr), s2, __ATOMIC_RELAXED, __HIP_MEMORY_SCOPE_AGENT); }
}
template <bool OUTF>
__device__ __forceinline__ void rms_row_fix(float* xrow, const float* g, void* orow, const LAS int* T, const float* slab, int ns, int m, int lane) {
    f32x4* xr = (f32x4*)xrow + lane; f32x4 v[8]; float s = 0.f; const int pm = m >> 8, rr = m & 255;
#pragma unroll
    for (int j = 0; j < 8; ++j) v[j] = xr[64 * j];
#pragma unroll
    for (int j = 0; j < 8; ++j) { const int t = T[pm * 8 + j];
        if (t >= 0) { const int cnt = ns > 0 ? ns : T[288 + pm * 8 + j]; const bf16* sp = (const bf16*)slab + ((size_t)t * (ns > 0 ? ns : 1) * 256 + rr) * 256 + 4 * lane;
            for (int q = 0; q < cnt; ++q) { const u32x2 w = *(const u32x2*)(sp + (size_t)q * 65536);
                v[j][0] += __builtin_bit_cast(float, w.x << 16); v[j][1] += __builtin_bit_cast(float, w.x & 0xffff0000u); v[j][2] += __builtin_bit_cast(float, w.y << 16); v[j][3] += __builtin_bit_cast(float, w.y & 0xffff0000u); }
            if (!OUTF) xr[64 * j] = v[j]; } }
#pragma unroll
    for (int j = 0; j < 8; ++j) s += (v[j][0] * v[j][0] + v[j][1] * v[j][1]) + (v[j][2] * v[j][2] + v[j][3] * v[j][3]);
    const float r = 1.f / sqrtf(wave_sum(s) * (1.f / DM) + EPS);
#pragma unroll
    for (int j = 0; j < 8; ++j) { const f32x4 gg = ((const f32x4*)g + lane)[64 * j];
        if (OUTF) __builtin_nontemporal_store(v[j] * r * gg, (f32x4*)orow + lane + 64 * j);
        else { u32x2 w; w.x = cvt_pk_bf16(v[j][0] * r * gg[0], v[j][1] * r * gg[1]); w.y = cvt_pk_bf16(v[j][2] * r * gg[2], v[j][3] * r * gg[3]); ((u32x2*)orow + lane)[64 * j] = w; } }
}

__device__ __forceinline__ void rms_row_final(f32x4 (&v)[8], const float* g, float* orow, const LAS int* T, const float* slab, int ns, int m, int lane) {
    float s = 0.f; const int pm = m >> 8, rr = m & 255;
#pragma unroll
    for (int j = 0; j < 8; ++j) { const int t = T[pm * 8 + j];
        if (t >= 0) { const bf16* sp = (const bf16*)slab + ((size_t)t * ns * 256 + rr) * 256 + 4 * lane;
            for (int q = 0; q < ns; ++q) { const u32x2 w = *(const u32x2*)(sp + (size_t)q * 65536);
                v[j][0] += __builtin_bit_cast(float, w.x << 16); v[j][1] += __builtin_bit_cast(float, w.x & 0xffff0000u); v[j][2] += __builtin_bit_cast(float, w.y << 16); v[j][3] += __builtin_bit_cast(float, w.y & 0xffff0000u); } } }
#pragma unroll
    for (int j = 0; j < 8; ++j) s += (v[j][0] * v[j][0] + v[j][1] * v[j][1]) + (v[j][2] * v[j][2] + v[j][3] * v[j][3]);
    const float r = 1.f / sqrtf(wave_sum(s) * (1.f / DM) + EPS);
#pragma unroll
    for (int j = 0; j < 8; ++j) { const f32x4 gg = ((const f32x4*)g + lane)[64 * j]; __builtin_nontemporal_store(v[j] * r * gg, (f32x4*)orow + lane + 64 * j); }
}

struct Args { const float* in[31]; float* out; unsigned char* ws; int ph_lo, ph_hi, li, pad; };

#define BSYNC() __syncthreads()

__device__ __forceinline__ void hg_cumsum_regs(const LAS float* Lb, LAS float* tot, int e, int part, float (&bv)[16], float (&pre)[5]) {
    float v[16];
#pragma unroll
    for (int i = 0; i < 16; ++i) v[i] = Lb[(16 * part + i) * 128 + e];
    float a = 0.f;
#pragma unroll
    for (int i = 0; i < 16; ++i) { a += v[i]; bv[i] = a; }
    tot[part * 128 + e] = a;
    BSYNC();
    const float t0 = tot[e], t1 = tot[128 + e], t2 = tot[256 + e], t3 = tot[384 + e];
    pre[0] = 0.f; pre[1] = t0; pre[2] = t0 + t1; pre[3] = (t0 + t1) + t2; pre[4] = ((t0 + t1) + t2) + t3;
    const float off = part == 0 ? pre[0] : (part == 1 ? pre[1] : (part == 2 ? pre[2] : pre[3]));
#pragma unroll
    for (int i = 0; i < 16; ++i) bv[i] += off;
}
__device__ __forceinline__ void hg_load_vt(const bf16* VH, int r0, int h, LAS bf16* VT, int tid) {
    const int s = tid >> 3, ch = tid & 7; const bf16* src = VH + (size_t)(r0 + s) * 1024 + h * 128 + 16 * ch;
    const v4u a = *(const v4u*)src, b = *(const v4u*)(src + 8);
    const unsigned w[8] = {a.x, a.y, a.z, a.w, b.x, b.y, b.z, b.w};
#pragma unroll
    for (int i = 0; i < 8; ++i) { VT[(16 * ch + 2 * i) * 72 + s] = (bf16)(w[i] & 0xffffu); VT[(16 * ch + 2 * i + 1) * 72 + s] = (bf16)(w[i] >> 16); }
}

__device__ __forceinline__ void hgrn_cs_load(const float* LOGF, const bf16* VH, int task, int tid, f32x4 (&lf)[4], v4u& va, v4u& vb) {
    const int n = task >> 8, h = (task >> 5) & 7, c = task & 31, r0 = n * 2048 + c * 64;
#pragma unroll
    for (int i = 0; i < 4; ++i) { const int idx = tid + 512 * i, s = idx >> 5, e4 = idx & 31; lf[i] = *(const f32x4*)(LOGF + (size_t)(r0 + s) * 1024 + h * 128 + 4 * e4); }
    const bf16* src = VH + (size_t)(r0 + (tid >> 3)) * 1024 + h * 128 + 16 * (tid & 7); va = *(const v4u*)src; vb = *(const v4u*)(src + 8);
}
__device__ __forceinline__ void hgrn_chunk_states(LAS unsigned char* lds, const float* LOGF, const bf16* VH, float* DS, float* DEC, int first, int last, int G, int tid) {
    LAS float* Lb = (LAS float*)lds; LAS float* Kk = (LAS float*)(lds + 32768); LAS bf16* KdT = (LAS bf16*)(lds + 65536); LAS bf16* VT = (LAS bf16*)(lds + 83968);
    if (first >= last) return;
    const int lane = tid & 63, w = tid >> 6, fr = lane & 15, fq = lane >> 4;
    f32x4 lf[4]; v4u va, vb;
    hgrn_cs_load(LOGF, VH, first, tid, lf, va, vb);
    for (int task = first; task < last; task += G) {
        __builtin_amdgcn_sched_barrier(0);
#pragma unroll
        for (int i = 0; i < 4; ++i) { const int idx = tid + 512 * i, s = idx >> 5, e4 = idx & 31; const f32x4 v = lf[i];
            *(LAS f32x4*)(Lb + s * 128 + 4 * e4) = v; f32x4 k; k[0] = 1.f - fexp(v[0]); k[1] = 1.f - fexp(v[1]); k[2] = 1.f - fexp(v[2]); k[3] = 1.f - fexp(v[3]); *(LAS f32x4*)(Kk + s * 128 + 4 * e4) = k; }
        { const int s = tid >> 3, ch = tid & 7; const unsigned wv[8] = {va.x, va.y, va.z, va.w, vb.x, vb.y, vb.z, vb.w};
#pragma unroll
          for (int i = 0; i < 8; ++i) { VT[(16 * ch + 2 * i) * 72 + s] = (bf16)(wv[i] & 0xffffu); VT[(16 * ch + 2 * i + 1) * 72 + s] = (bf16)(wv[i] >> 16); } }
        __builtin_amdgcn_sched_barrier(0);
        if (task + G < last) hgrn_cs_load(LOGF, VH, task + G, tid, lf, va, vb);
        __builtin_amdgcn_sched_barrier(0);
        BSYNC();
        { const int e = tid & 127, part = __builtin_amdgcn_readfirstlane(tid >> 7); float bv[16], pre[5], kd[16];
          hg_cumsum_regs(Lb, (LAS float*)(lds + 102400), e, part, bv, pre); const float bend = pre[4];
#pragma unroll
          for (int i = 0; i < 16; ++i) { const int s = 16 * part + i; kd[i] = Kk[s * 128 + e] * fexp(bend - bv[i]); }
          v4u o0, o1; o0.x = cvt_pk_bf16(kd[0], kd[1]); o0.y = cvt_pk_bf16(kd[2], kd[3]); o0.z = cvt_pk_bf16(kd[4], kd[5]); o0.w = cvt_pk_bf16(kd[6], kd[7]);
          o1.x = cvt_pk_bf16(kd[8], kd[9]); o1.y = cvt_pk_bf16(kd[10], kd[11]); o1.z = cvt_pk_bf16(kd[12], kd[13]); o1.w = cvt_pk_bf16(kd[14], kd[15]);
          *(LAS v4u*)(KdT + e * 72 + 16 * part) = o0; *(LAS v4u*)(KdT + e * 72 + 16 * part + 8) = o1;
          if (part == 0) DEC[(size_t)task * 128 + e] = fexp(bend); }
        BSYNC();
        f32x4 acc[8];
#pragma unroll
        for (int et = 0; et < 8; ++et) acc[et] = (f32x4){0.f, 0.f, 0.f, 0.f};
#pragma unroll
        for (int ks = 0; ks < 2; ++ks) { const bf16x8 a = *(const LAS bf16x8*)(VT + (16 * w + fr) * 72 + 32 * ks + 8 * fq);
#pragma unroll
            for (int et = 0; et < 8; ++et) { const bf16x8 b = *(const LAS bf16x8*)(KdT + (16 * et + fr) * 72 + 32 * ks + 8 * fq); acc[et] = __builtin_amdgcn_mfma_f32_16x16x32_bf16(a, b, acc[et], 0, 0, 0); } }
        float* dst = DS + (size_t)task * 16384;
#pragma unroll
        for (int et = 0; et < 8; ++et)
#pragma unroll
            for (int r = 0; r < 4; ++r) dst[(16 * w + 4 * fq + r) * 128 + 16 * et + fr] = acc[et][r];
        BSYNC();
    }
}

__device__ __forceinline__ void hgrn_co_load_a(const float* LOGF, const bf16* VH, int task, int tid, f32x4 (&lf)[4], v4u& va, v4u& vb) {
    const int n = task >> 8, h = (task >> 5) & 7, c = task & 31, r0 = n * 2048 + c * 64;
#pragma unroll
    for (int i = 0; i < 4; ++i) { const int idx = tid + 512 * i, s = idx >> 5, e4 = idx & 31; lf[i] = *(const f32x4*)(LOGF + (size_t)(r0 + s) * 1024 + h * 128 + 4 * e4); }
    const bf16* vsrc = VH + (size_t)(r0 + (tid >> 3)) * 1024 + h * 128 + 16 * (tid & 7); va = *(const v4u*)vsrc; vb = *(const v4u*)(vsrc + 8);
}
__device__ __forceinline__ void hgrn_co_load_b(const bf16* QH, const bf16* SST, int task, int tid, float (&qv)[16], v4u (&sst)[4]) {
    const int n = task >> 8, h = (task >> 5) & 7, c = task & 31, r0 = n * 2048 + c * 64;
#pragma unroll
    for (int i = 0; i < 16; ++i) qv[i] = bf2f(QH[(size_t)(r0 + 16 * (tid >> 7) + i) * 1024 + h * 128 + (tid & 127)]);
#pragma unroll
    for (int i = 0; i < 4; ++i) { const int idx = tid + 512 * i, d = idx >> 4, ch = idx & 15; sst[i] = *(const v4u*)(SST + (size_t)task * 16384 + d * 128 + 8 * ch); }
}
__device__ __forceinline__ void hgrn_chunk_outs(LAS unsigned char* lds, const float* LOGF, const bf16* QH, const bf16* VH, const bf16* GH, const bf16* SST, const float* gnorm, bf16* OB, int first, int last, int G, int tid) {
    LAS float* Lb = (LAS float*)lds; LAS bf16* SsT = (LAS bf16*)lds; LAS bf16* Qb = (LAS bf16*)(lds + 34816); LAS bf16* Qp = (LAS bf16*)(lds + 52224);
    LAS bf16* Kt = (LAS bf16*)(lds + 69632); LAS bf16* VT = (LAS bf16*)(lds + 113152); LAS bf16* Ab = (LAS bf16*)(lds + 131584); LAS float* red = (LAS float*)(lds + 140800);
    if (first >= last) return;
    const int lane = tid & 63, w = tid >> 6, fr = lane & 15, fq = lane >> 4;
    const int tt = w & 3, dh = w >> 2;
    f32x4 lf[4]; v4u sst[4], va, vb; float qv[16]; float gn[4];
#pragma unroll
    for (int k = 0; k < 4; ++k) gn[k] = gnorm[16 * (4 * dh + k) + fr];
    hgrn_co_load_a(LOGF, VH, first, tid, lf, va, vb); hgrn_co_load_b(QH, SST, first, tid, qv, sst);
    for (int task = first; task < last; task += G) {
    const int n = task >> 8, h = (task >> 5) & 7, c = task & 31, r0 = n * 2048 + c * 64;
    bf16 ghv[4][4];
#pragma unroll
    for (int r = 0; r < 4; ++r)
#pragma unroll
        for (int k = 0; k < 4; ++k) ghv[r][k] = GH[(size_t)(r0 + 16 * tt + 4 * fq + r) * 1024 + h * 128 + 16 * (4 * dh + k) + fr];
    __builtin_amdgcn_sched_barrier(0);
#pragma unroll
    for (int i = 0; i < 4; ++i) { const int idx = tid + 512 * i, s = idx >> 5, e4 = idx & 31; *(LAS f32x4*)(Lb + s * 128 + 4 * e4) = lf[i]; }
    { const int s = tid >> 3, ch = tid & 7; const unsigned wv[8] = {va.x, va.y, va.z, va.w, vb.x, vb.y, vb.z, vb.w};
#pragma unroll
      for (int i = 0; i < 8; ++i) { VT[(16 * ch + 2 * i) * 72 + s] = (bf16)(wv[i] & 0xffffu); VT[(16 * ch + 2 * i + 1) * 72 + s] = (bf16)(wv[i] >> 16); } }
    for (int i = tid; i < 64 * 72 / 2; i += NTHR) ((LAS unsigned*)Ab)[i] = 0u;
    __builtin_amdgcn_sched_barrier(0);
    if (task + G < last) hgrn_co_load_a(LOGF, VH, task + G, tid, lf, va, vb);
    __builtin_amdgcn_sched_barrier(0);
    BSYNC();
    { const int e = tid & 127, part = __builtin_amdgcn_readfirstlane(tid >> 7); float bv[16], pre[5];
      hg_cumsum_regs(Lb, (LAS float*)(lds + 141312), e, part, bv, pre);
      const float rmine = part == 0 ? pre[0] : (part == 1 ? pre[1] : (part == 2 ? pre[2] : pre[3]));
      const float c0 = fexp(rmine); float cK[4];
#pragma unroll
      for (int ip = 0; ip < 4; ++ip) cK[ip] = fexp(pre[ip] - rmine);
#pragma unroll
      for (int i = 0; i < 16; ++i) { const int t = 16 * part + i; const float b = bv[i]; const float bprev = i > 0 ? bv[i - 1] : rmine;
          const float k = 1.f - fexp(b - bprev); const float e1 = fexp(rmine - b); const float qp = qv[i] * __builtin_amdgcn_rcpf(e1); const float ke = k * e1;
          { const unsigned qq = cvt_pk_bf16(qp * c0, qp); Qb[t * 136 + e] = (bf16)(qq & 0xffffu); Qp[t * 136 + e] = (bf16)(qq >> 16); }
          const unsigned k01 = cvt_pk_bf16(ke * cK[0], ke * cK[1]), k23 = cvt_pk_bf16(ke * cK[2], ke * cK[3]);
#pragma unroll
          for (int ip = 0; ip < 4; ++ip) if (ip >= part) { const unsigned kk = ip < 2 ? k01 : k23; Kt[(8 * ip * (ip + 1) + t) * 136 + e] = (bf16)((ip & 1) ? (kk >> 16) : (kk & 0xffffu)); } } }
    BSYNC();
#pragma unroll
    for (int i = 0; i < 4; ++i) { const int idx = tid + 512 * i, d = idx >> 4, ch = idx & 15; *(LAS v4u*)(SsT + d * 136 + 8 * ch) = sst[i]; }
    for (int tl = w; tl < 10; tl += 8) { const int i = tl < 1 ? 0 : (tl < 3 ? 1 : (tl < 6 ? 2 : 3)), j = tl - (i * (i + 1)) / 2;
        f32x4 a4 = (f32x4){0.f, 0.f, 0.f, 0.f};
#pragma unroll
        for (int ks = 0; ks < 4; ++ks) { const bf16x8 a = *(const LAS bf16x8*)(Qp + (16 * i + fr) * 136 + 32 * ks + 8 * fq); const bf16x8 b = *(const LAS bf16x8*)(Kt + (8 * i * (i + 1) + 16 * j + fr) * 136 + 32 * ks + 8 * fq);
            a4 = __builtin_amdgcn_mfma_f32_16x16x32_bf16(a, b, a4, 0, 0, 0); }
#pragma unroll
        for (int r = 0; r < 4; ++r) { float v = a4[r]; if (i == j && fr > 4 * fq + r) v = 0.f; Ab[(16 * i + 4 * fq + r) * 72 + 16 * j + fr] = (bf16)f2bf(v); } }
    __builtin_amdgcn_sched_barrier(0);
    if (task + G < last) hgrn_co_load_b(QH, SST, task + G, tid, qv, sst);
    __builtin_amdgcn_sched_barrier(0);
    BSYNC();
    f32x4 acc[4];
#pragma unroll
    for (int k = 0; k < 4; ++k) acc[k] = (f32x4){0.f, 0.f, 0.f, 0.f};
#pragma unroll
    for (int ks = 0; ks < 2; ++ks) { const bf16x8 a = *(const LAS bf16x8*)(Ab + (16 * tt + fr) * 72 + 32 * ks + 8 * fq);
#pragma unroll
        for (int k = 0; k < 4; ++k) { const bf16x8 b = *(const LAS bf16x8*)(VT + (16 * (4 * dh + k) + fr) * 72 + 32 * ks + 8 * fq); acc[k] = __builtin_amdgcn_mfma_f32_16x16x32_bf16(a, b, acc[k], 0, 0, 0); } }
#pragma unroll
    for (int ks = 0; ks < 4; ++ks) { const bf16x8 a = *(const LAS bf16x8*)(Qb + (16 * tt + fr) * 136 + 32 * ks + 8 * fq);
#pragma unroll
        for (int k = 0; k < 4; ++k) { const bf16x8 b = *(const LAS bf16x8*)(SsT + (16 * (4 * dh + k) + fr) * 136 + 32 * ks + 8 * fq); acc[k] = __builtin_amdgcn_mfma_f32_16x16x32_bf16(a, b, acc[k], 0, 0, 0); } }
#pragma unroll
    for (int r = 0; r < 4; ++r) { float ss = 0.f;
#pragma unroll
        for (int k = 0; k < 4; ++k) ss += acc[k][r] * acc[k][r];
        ss += __shfl_xor(ss, 1); ss += __shfl_xor(ss, 2); ss += __shfl_xor(ss, 4); ss += __shfl_xor(ss, 8);
        if (fr == 0) red[(16 * tt + 4 * fq + r) * 2 + dh] = ss; }
    BSYNC();
#pragma unroll
    for (int r = 0; r < 4; ++r) { const int t = 16 * tt + 4 * fq + r; const float rs = 1.f / sqrtf((red[t * 2] + red[t * 2 + 1]) * (1.f / 128.f) + EPS); const size_t row = (size_t)(r0 + t);
#pragma unroll
        for (int k = 0; k < 4; ++k) { const int d = 16 * (4 * dh + k) + fr; const float v = acc[k][r] * rs * gn[k] * bf2f(ghv[r][k]); OB[row * 2048 + h * 128 + d] = (bf16)f2bf(v); } }
    BSYNC();
    }
}

__device__ __forceinline__ void hgrn_sample_load(const float* LOGF, const bf16* QH, const bf16* VH, const bf16* GH, const float* S0g, int task, int tid, f32x4 (&s0)[8], unsigned& gg, float (&sm)[6]) {
    const int n = task >> 3, h = task & 7, r0 = MP + n * 8;
    const float* sp = S0g + ((size_t)task * 128 + 8 * (tid >> 5)) * 128 + 4 * (tid & 31);
#pragma unroll
    for (int k = 0; k < 8; ++k) s0[k] = __builtin_nontemporal_load((const f32x4*)(sp + k * 128));
    gg = *(const unsigned*)(GH + (size_t)(r0 + (tid >> 6)) * 1024 + h * 128 + 2 * (tid & 63));
#pragma unroll
    for (int i = 0; i < 2; ++i) { const int idx = tid + 512 * i, t = idx >> 7, e = idx & 127; const size_t g = (size_t)(r0 + t) * 1024 + h * 128 + e; sm[3 * i] = LOGF[g]; sm[3 * i + 1] = bf2f(QH[g]); sm[3 * i + 2] = bf2f(VH[g]); }
}
__device__ __forceinline__ void hgrn_samples(LAS unsigned char* lds, const float* LOGF, const bf16* QH, const bf16* VH, const bf16* GH, const float* S0g, float* Sout, const float* gnorm, bf16* OB, int first, int last, int G, int tid) {
    if (first >= last) return;
    f32x4 s0[8]; unsigned gg, ggn = 0u; float sm[6];
    const float gn0 = gnorm[2 * (tid & 63)], gn1 = gnorm[2 * (tid & 63) + 1];
    hgrn_sample_load(LOGF, QH, VH, GH, S0g, first, tid, s0, gg, sm);
    for (int task = first; task < last; task += G) {
    LAS float* bb = (LAS float*)lds; LAS float* qb = (LAS float*)(lds + 4096); LAS float* kd = (LAS float*)(lds + 8192); LAS float* vv = (LAS float*)(lds + 12288);
    LAS float* dec = (LAS float*)(lds + 16384); LAS float* Am = (LAS float*)(lds + 16896); LAS float* qraw = (LAS float*)(lds + 17408); LAS float* kraw = (LAS float*)(lds + 21504);
    LAS float* red = (LAS float*)(lds + 32768);
    const int n = task >> 3, h = task & 7, r0 = MP + n * 8;
    __builtin_amdgcn_sched_barrier(0);
#pragma unroll
    for (int i = 0; i < 2; ++i) { const int idx = tid + 512 * i;
        const float lf = sm[3 * i]; bb[idx] = lf; kraw[idx] = 1.f - fexp(lf); qraw[idx] = sm[3 * i + 1]; vv[idx] = sm[3 * i + 2]; }
    BSYNC();
    if (tid < 128) { const int e = tid; float a = 0.f; float bl[8];
#pragma unroll
        for (int t = 0; t < 8; ++t) { a += bb[t * 128 + e]; bl[t] = a; bb[t * 128 + e] = a; }
        dec[e] = fexp(a);
#pragma unroll
        for (int t = 0; t < 8; ++t) { qb[t * 128 + e] = qraw[t * 128 + e] * fexp(bl[t]); kd[t * 128 + e] = kraw[t * 128 + e] * fexp(a - bl[t]); } }
    BSYNC();
    { const int pair = tid >> 3, t = pair >> 3, s = pair & 7, es = tid & 7; float sum = 0.f;
      if (s <= t) {
#pragma unroll
          for (int i = 0; i < 16; ++i) { const int e = 16 * es + i; sum += qraw[t * 128 + e] * kraw[s * 128 + e] * fexp(bb[t * 128 + e] - bb[s * 128 + e]); } }
      sum += __shfl_xor(sum, 1); sum += __shfl_xor(sum, 2); sum += __shfl_xor(sum, 4);
      if (es == 0) Am[t * 8 + s] = sum; }
    { const int dq = tid & 31, eg = tid >> 5; f32x4 v4[8], po[8];
#pragma unroll
      for (int s = 0; s < 8; ++s) { v4[s] = *(const LAS f32x4*)(vv + s * 128 + 4 * dq); po[s] = (f32x4){0.f, 0.f, 0.f, 0.f}; }
      float* op = Sout + ((size_t)task * 128 + 8 * eg) * 128 + 4 * dq;
#pragma unroll
      for (int k = 0; k < 8; ++k) { const int e = 8 * eg + k; f32x4 sn = s0[k] * dec[e];
#pragma unroll
          for (int t = 0; t < 8; ++t) { po[t] += s0[k] * qb[t * 128 + e]; sn += v4[t] * kd[t * 128 + e]; }
          __builtin_nontemporal_store(sn, (f32x4*)(op + k * 128)); }
#pragma unroll
      for (int t = 0; t < 8; ++t) *(LAS f32x4*)(red + (eg * 8 + t) * 128 + 4 * dq) = po[t]; }
    __builtin_amdgcn_sched_barrier(0);
    if (task + G < last) hgrn_sample_load(LOGF, QH, VH, GH, S0g, task + G, tid, s0, ggn, sm);
    __builtin_amdgcn_sched_barrier(0);
    BSYNC();
    { const int t = tid >> 6, dp = tid & 63; float o0 = 0.f, o1 = 0.f;
#pragma unroll
      for (int eg = 0; eg < 16; ++eg) { o0 += red[(eg * 8 + t) * 128 + 2 * dp]; o1 += red[(eg * 8 + t) * 128 + 2 * dp + 1]; }
#pragma unroll
      for (int s = 0; s < 8; ++s) { const float a = Am[t * 8 + s]; o0 += a * vv[s * 128 + 2 * dp]; o1 += a * vv[s * 128 + 2 * dp + 1]; }
      const float rs = 1.f / sqrtf(wave_sum(o0 * o0 + o1 * o1) * (1.f / 128.f) + EPS); const size_t row = (size_t)(r0 + t); const int d = 2 * dp;
      *(unsigned*)(OB + row * 2048 + h * 128 + d) = cvt_pk_bf16(o0 * rs * gn0 * bf2f((bf16)(gg & 0xffffu)), o1 * rs * gn1 * bf2f((bf16)(gg >> 16))); }
    BSYNC();
    gg = ggn;
    }
}

typedef float cf32x2 __attribute__((ext_vector_type(2)));
template <bool SAMPLE>
__device__ __forceinline__ void conv_load_rows(const float* U, const float* sconv, int task, int c0, cf32x2 (&rows)[38]) {
    const int n = SAMPLE ? task - 1024 : task >> 8, t0 = SAMPLE ? 0 : (task & 255) * 8; const int urow0 = SAMPLE ? MP + n * 8 : n * 2048 + t0;
#pragma unroll
    for (int r = 0; r < 38; ++r) {
        if (SAMPLE) { rows[r] = (r < 30) ? *(const cf32x2*)(sconv + ((size_t)n * 30 + (r < 30 ? r : 0)) * 1024 + c0) : *(const cf32x2*)(U + (size_t)(urow0 + r - 30) * 1024 + c0); }
        else { const int dr = t0 + r - 30; const int rowc = n * 2048 + (dr > 0 ? dr : 0); rows[r] = *(const cf32x2*)(U + (size_t)rowc * 1024 + c0); }
    }
}
template <bool SAMPLE>
__device__ __forceinline__ void conv_tasks(LAS unsigned char* lds, const float* U, const float* sconv, const float* cw, const float* cb, const float* lg, const float* lbeta, bf16* OB, int first, int last, int G, int tid) {
    LAS float* red = (LAS float*)lds;
    LAS float* tot = (LAS float*)(lds + 1024);
    if (first >= last) return;
    const int c0 = 2 * tid, lane = tid & 63, w = tid >> 6;
    typedef cf32x2 f32x2;
    f32x2 wj[31];
#pragma unroll
    for (int j = 0; j < 31; ++j) wj[j] = *(const f32x2*)(cw + j * 1024 + c0);
    const f32x2 bias = *(const f32x2*)(cb + c0), g2 = *(const f32x2*)(lg + c0), b2 = *(const f32x2*)(lbeta + c0);
    f32x2 rows[38];
    conv_load_rows<SAMPLE>(U, sconv, first, c0, rows);
    for (int task = first; task < last; task += G) {
        const int n = SAMPLE ? task - 1024 : task >> 8, t0 = SAMPLE ? 0 : (task & 255) * 8; const int urow0 = SAMPLE ? MP + n * 8 : n * 2048 + t0;
        f32x2 acc[8];
#pragma unroll
        for (int k = 0; k < 8; ++k) acc[k] = bias;
        __builtin_amdgcn_sched_barrier(0);
#pragma unroll
        for (int r = 0; r < 38; ++r) {
            f32x2 v = rows[r];
            if (!SAMPLE && r < 30) v = v * ((t0 + r - 30) >= 0 ? 1.f : 0.f);
#pragma unroll
            for (int k = 0; k < 8; ++k) { const int j = r - k; if (j >= 0 && j <= 30) acc[k] += wj[j] * v; }
        }
        __builtin_amdgcn_sched_barrier(0);
        if (task + G < last) conv_load_rows<SAMPLE>(U, sconv, task + G, c0, rows);
        __builtin_amdgcn_sched_barrier(0);
#pragma unroll
        for (int k = 0; k < 8; ++k) { const float s1 = wave_sum(acc[k][0] + acc[k][1]), s2 = wave_sum(acc[k][0] * acc[k][0] + acc[k][1] * acc[k][1]); if (lane == 0) { red[w * 16 + 2 * k] = s1; red[w * 16 + 2 * k + 1] = s2; } }
        BSYNC();
        if (tid < 16) { float s = 0.f;
#pragma unroll
            for (int ww = 0; ww < 8; ++ww) s += red[ww * 16 + tid];
            tot[tid] = s; }
        BSYNC();
#pragma unroll
        for (int k = 0; k < 8; ++k) { const float mu = tot[2 * k] * (1.f / 1024.f); const float var = tot[2 * k + 1] * (1.f / 1024.f) - mu * mu; const float rstd = __builtin_amdgcn_rsqf(fmaxf(var, 0.f) + EPS);
            const float y0 = (acc[k][0] - mu) * rstd * g2[0] + b2[0], y1 = (acc[k][1] - mu) * rstd * g2[1] + b2[1];
            *(unsigned*)(OB + (size_t)(urow0 + k) * 2048 + 1024 + c0) = cvt_pk_bf16(fsilu(y0), fsilu(y1)); }
        BSYNC();
    }
}

__device__ __forceinline__ void attn_unit(LAS unsigned char* lds, const bf16* QB, const bf16* KBp, const bf16* VBT, bf16* AO, int unit, int tid) {
    constexpr int KS = 136, VS = 264;
    LAS bf16* Ks = (LAS bf16*)lds;
    LAS bf16* VTs = (LAS bf16*)(lds + 69632);
    const int n = unit >> 6, h = (unit >> 4) & 3, qrow0 = n * 2048 + (unit & 15) * 128;
    const int lane = tid & 63, w = tid >> 6, fr = lane & 15, fq = lane >> 4;
    bf16x8 qf[4]; v4u kreg[8], vreg[8];
    { const bf16* qp = QB + (size_t)(qrow0 + 16 * w + fr) * XDIM + h * 128 + 8 * fq;
#pragma unroll
      for (int ks = 0; ks < 4; ++ks) qf[ks] = *(const bf16x8*)(qp + 32 * ks);
      const int key = tid >> 1, half = tid & 1; const bf16* kp = KBp + ((size_t)(n * 256 + key)) * XDIM + h * 128 + 64 * half;
#pragma unroll
      for (int i = 0; i < 8; ++i) kreg[i] = *(const v4u*)(kp + 8 * i);
#pragma unroll
      for (int i = 0; i < 8; ++i) { const int idx = tid + 512 * i, d = idx >> 5, ch = idx & 31; vreg[i] = *(const v4u*)(VBT + ((size_t)(n * 4 + h) * 128 + d) * 256 + 8 * ch); }
      __builtin_amdgcn_sched_barrier(0);
#pragma unroll
      for (int i = 0; i < 8; ++i) *(LAS v4u*)(Ks + key * KS + 64 * half + 8 * i) = kreg[i];
#pragma unroll
      for (int i = 0; i < 8; ++i) { const int idx = tid + 512 * i, d = idx >> 5, ch = idx & 31; *(LAS v4u*)(VTs + d * VS + 8 * ch) = vreg[i]; } }
    BSYNC();
    f32x4 sc[16]; float rsum[4];
#pragma unroll
    for (int nt = 0; nt < 16; ++nt) { sc[nt] = (f32x4){0.f, 0.f, 0.f, 0.f};
#pragma unroll
        for (int ks = 0; ks < 4; ++ks) { const bf16x8 b = *(const LAS bf16x8*)(Ks + (16 * nt + fr) * KS + 32 * ks + 8 * fq); sc[nt] = __builtin_amdgcn_mfma_f32_16x16x32_bf16(qf[ks], b, sc[nt], 0, 0, 0); } }
#pragma unroll
    for (int r = 0; r < 4; ++r) { float mx = sc[0][r];
#pragma unroll
        for (int nt = 1; nt < 16; ++nt) mx = fmaxf(mx, sc[nt][r]);
        mx = fmaxf(mx, __shfl_xor(mx, 1)); mx = fmaxf(mx, __shfl_xor(mx, 2)); mx = fmaxf(mx, __shfl_xor(mx, 4)); mx = fmaxf(mx, __shfl_xor(mx, 8));
        float s = 0.f;
#pragma unroll
        for (int nt = 0; nt < 16; ++nt) { const float p = fexp(sc[nt][r] - mx); sc[nt][r] = p; s += p; }
        s += __shfl_xor(s, 1); s += __shfl_xor(s, 2); s += __shfl_xor(s, 4); s += __shfl_xor(s, 8); rsum[r] = s; }
    BSYNC();
    LAS bf16* Pw = (LAS bf16*)(lds + w * 8448);
#pragma unroll
    for (int nt = 0; nt < 16; ++nt)
#pragma unroll
        for (int r = 0; r < 4; r += 2) { const unsigned pp = cvt_pk_bf16(sc[nt][r], sc[nt][r + 1]); Pw[(4 * fq + r) * VS + 16 * nt + fr] = (bf16)(pp & 0xffffu); Pw[(4 * fq + r + 1) * VS + 16 * nt + fr] = (bf16)(pp >> 16); }
    LDS_WAIT(); asm volatile("" ::: "memory");
    f32x4 oc[8];
#pragma unroll
    for (int dt = 0; dt < 8; ++dt) oc[dt] = (f32x4){0.f, 0.f, 0.f, 0.f};
#pragma unroll
    for (int ks = 0; ks < 8; ++ks) { const bf16x8 a = *(const LAS bf16x8*)(Pw + fr * VS + 32 * ks + 8 * fq);
#pragma unroll
        for (int dt = 0; dt < 8; ++dt) { const bf16x8 b = *(const LAS bf16x8*)(VTs + (16 * dt + fr) * VS + 32 * ks + 8 * fq); oc[dt] = __builtin_amdgcn_mfma_f32_16x16x32_bf16(a, b, oc[dt], 0, 0, 0); } }
#pragma unroll
    for (int r = 0; r < 4; ++r) { const float inv = 1.f / rsum[r]; const size_t row = (size_t)(qrow0 + 16 * w + 4 * fq + r);
#pragma unroll
        for (int dt = 0; dt < 8; ++dt) AO[row * XDIM + h * 128 + 16 * dt + fr] = (bf16)f2bf(oc[dt][r] * inv); }
    BSYNC();
}
__device__ __forceinline__ void attn_sample_load_k(const bf16* QB, const float* ck, int s, int tid, f32x4 (&kreg)[4][4], unsigned& qraw) {
    const int n = s >> 2, h = s & 3, qrow0 = MP + n * 8; const int lane = tid & 63, w = __builtin_amdgcn_readfirstlane(tid >> 6);
    const int koff = (tid >> 3) * 512 + 16 * (tid & 7);
#pragma unroll
    for (int p = 0; p < 4; ++p) { const float* kb = ck + (((size_t)n * 256 + 64 * p) * 4 + h) * 128;
#pragma unroll
        for (int i = 0; i < 4; ++i) kreg[p][i] = __builtin_nontemporal_load((const f32x4*)(kb + koff + 4 * i)); }
    qraw = *(const unsigned*)(QB + (size_t)(qrow0 + w) * XDIM + h * 128 + 2 * lane);
}
__device__ __forceinline__ void attn_samples(LAS unsigned char* lds, const bf16* QB, const float* ck, const float* cv, bf16* AO, int first, int last, int G, int tid) {
    if (first >= last) return;
    f32x4 kreg[4][4]; unsigned qraw;
    attn_sample_load_k(QB, ck, first, tid, kreg, qraw);
    for (int s = first; s < last; s += G) {
    typedef float f32x2 __attribute__((ext_vector_type(2)));
    LAS float* Qs = (LAS float*)lds;
    LAS float* Ss = (LAS float*)(lds + 4096);
    LAS float* Pt = (LAS float*)(lds + 12288);
    LAS float* red = (LAS float*)(lds + 20480);
    const int n = s >> 2, h = s & 3, qrow0 = MP + n * 8; const int lane = tid & 63, w = __builtin_amdgcn_readfirstlane(tid >> 6);
    const int key_l = tid >> 3, dseg = tid & 7, d2 = tid & 63, kg = w;
    f32x2 vreg[32];
    __builtin_amdgcn_sched_barrier(0);
    Qs[w * 128 + 2 * lane] = bf2f((bf16)(qraw & 0xffffu)); Qs[w * 128 + 2 * lane + 1] = bf2f((bf16)(qraw >> 16));
    BSYNC();
#pragma unroll
    for (int p = 0; p < 4; ++p) { float a[8];
#pragma unroll
        for (int q = 0; q < 8; ++q) a[q] = 0.f;
#pragma unroll
        for (int i = 0; i < 4; ++i) { const f32x4 kv = kreg[p][i];
#pragma unroll
            for (int q = 0; q < 8; ++q) { const f32x4 qv = *(const LAS f32x4*)(Qs + q * 128 + 16 * dseg + 4 * i); a[q] += (kv[0] * qv[0] + kv[1] * qv[1]) + (kv[2] * qv[2] + kv[3] * qv[3]); } }
        float mine = 0.f;
#pragma unroll
        for (int q = 0; q < 8; ++q) { float v = a[q]; v += __shfl_xor(v, 1); v += __shfl_xor(v, 2); v += __shfl_xor(v, 4); if (dseg == q) mine = v; }
        Ss[dseg * 256 + 64 * p + key_l] = mine; }
    __builtin_amdgcn_sched_barrier(0);
#pragma unroll
    for (int j = 0; j < 32; ++j) { const float* vb = cv + (((size_t)n * 256 + 32 * kg + j) * 4 + h) * 128; vreg[j] = __builtin_nontemporal_load((const f32x2*)(vb + 2 * d2)); }
    if (s + G < last) attn_sample_load_k(QB, ck, s + G, tid, kreg, qraw);
    __builtin_amdgcn_sched_barrier(0);
    BSYNC();
    { const f32x4 sv = *(const LAS f32x4*)(Ss + w * 256 + 4 * lane); float mx = fmaxf(fmaxf(sv[0], sv[1]), fmaxf(sv[2], sv[3]));
#pragma unroll
      for (int o = 1; o < 64; o <<= 1) mx = fmaxf(mx, __shfl_xor(mx, o));
      f32x4 e; e[0] = fexp(sv[0] - mx); e[1] = fexp(sv[1] - mx); e[2] = fexp(sv[2] - mx); e[3] = fexp(sv[3] - mx);
      const float inv = 1.f / wave_sum((e[0] + e[1]) + (e[2] + e[3]));
#pragma unroll
      for (int i = 0; i < 4; ++i) Pt[(4 * lane + i) * 8 + w] = e[i] * inv; }
    BSYNC();
    { f32x2 o[8];
#pragma unroll
      for (int q = 0; q < 8; ++q) o[q] = (f32x2){0.f, 0.f};
#pragma unroll
      for (int j = 0; j < 32; ++j) { const f32x4 p0 = *(const LAS f32x4*)(Pt + (32 * kg + j) * 8), p1 = *(const LAS f32x4*)(Pt + (32 * kg + j) * 8 + 4);
#pragma unroll
          for (int q = 0; q < 4; ++q) { o[q] += vreg[j] * p0[q]; o[q + 4] += vreg[j] * p1[q]; } }
#pragma unroll
      for (int q = 0; q < 8; ++q) *(LAS f32x2*)(red + (kg * 8 + q) * 128 + 2 * d2) = o[q]; }
    BSYNC();
    { const int q = tid >> 6; f32x2 o = (f32x2){0.f, 0.f};
#pragma unroll
      for (int g = 0; g < 8; ++g) o += *(const LAS f32x2*)(red + (g * 8 + q) * 128 + 2 * d2);
      *(unsigned*)(AO + (size_t)(qrow0 + q) * XDIM + h * 128 + 2 * d2) = cvt_pk_bf16(o[0], o[1]); }
    BSYNC();
    }
}

constexpr int I_GU = 32 * 176, I_D = 88 * 64, I_IN = 32 * 192, I_OUT = 32 * 64, I_Q = 32 * 16, I_O = 8 * 64;
static_assert(I_D == I_GU, "items");
constexpr int SEG0 = 2 * I_GU + 2 * I_Q, SEG1 = I_GU + I_IN, SEG2 = I_OUT + I_Q + I_O + I_GU, SEG3 = 2 * I_GU;
__device__ __forceinline__ void convert_items(const Args& args, unsigned char* ws, LAS unsigned char* lds, int seg, int wid, int nw, int wave, int lane) {
    LAS float* scr = (LAS float*)(lds + wave * 16384);
    bf16* Wgu1 = (bf16*)(ws + WS_WGU1); bf16* Wd1 = (bf16*)(ws + WS_WD1); bf16* Win = (bf16*)(ws + WS_WIN); bf16* Wout = (bf16*)(ws + WS_WOUT);
    bf16* Wq = (bf16*)(ws + WS_WQ); bf16* Wkv = (bf16*)(ws + WS_WKV); bf16* Wo = (bf16*)(ws + WS_WO); bf16* Wgu2 = (bf16*)(ws + WS_WGU2); bf16* Wd2 = (bf16*)(ws + WS_WD2);
    const int total = seg == 0 ? SEG0 : (seg == 1 ? SEG1 : (seg == 2 ? SEG2 : SEG3));
    for (int it = wid; it < total; it += nw) {
        int r = it;
        if (seg == 0) {
            if (r < 2 * I_GU) { const int which = r / I_GU; r -= which * I_GU; const int kb = r / 176, nb = r % 176; p0_transpose_item(which == 0 ? args.in[8] : args.in[9], DM, DFF, Wgu1, map_pair(32 * nb, which), scr, 64 * kb, 32 * nb, lane); continue; }
            r -= 2 * I_GU; { const int which = r / I_Q; r -= which * I_Q; const int kb = r / 16, nb = r % 16; p0_transpose_item(which == 0 ? args.in[23] : args.in[24], DM, XDIM, Wkv, which * 512 + 32 * nb, scr, 64 * kb, 32 * nb, lane); }
        } else if (seg == 1) {
            if (r < I_GU) { const int kb = r / 64, nb = r % 64; p0_transpose_item(args.in[10], DFF, DM, Wd1, 32 * nb, scr, 64 * kb, 32 * nb, lane); continue; }
            r -= I_GU; { const int kb = r / 192, nb = r % 192, n0 = 32 * nb; const int dr = n0 < 4096 ? n0 : (n0 < 5120 ? 4096 + map_pair(n0 - 4096, 0) : 4096 + map_pair(n0 - 5120, 1));
                p0_transpose_item(args.in[12], DM, DIN, Win, dr, scr, 64 * kb, n0, lane, args.in[11]); }
        } else if (seg == 2) {
            if (r < I_OUT) { const int kb = r / 64, nb = r % 64; p0_transpose_item(args.in[19], DM, DM, Wout, 32 * nb, scr, 64 * kb, 32 * nb, lane); continue; }
            r -= I_OUT;
            if (r < I_Q) { const int kb = r / 16, nb = r % 16; p0_transpose_item(args.in[22], DM, XDIM, Wq, 32 * nb, scr, 64 * kb, 32 * nb, lane, args.in[20]); continue; }
            r -= I_Q;
            if (r < I_O) { const int kb = r / 64, nb = r % 64; p0_transpose_item(args.in[25], XDIM, DM, Wo, 32 * nb, scr, 64 * kb, 32 * nb, lane); continue; }
            r -= I_O; { const int kb = r / 176, nb = r % 176; p0_transpose_item(args.in[27], DM, DFF, Wgu2, map_pair(32 * nb, 0), scr, 64 * kb, 32 * nb, lane, args.in[26]); }
        } else {
            if (r < I_GU) { const int kb = r / 176, nb = r % 176; p0_transpose_item(args.in[28], DM, DFF, Wgu2, map_pair(32 * nb, 1), scr, 64 * kb, 32 * nb, lane, args.in[26]); continue; }
            r -= I_GU; { const int kb = r / 64, nb = r % 64; p0_transpose_item(args.in[29], DFF, DM, Wd2, 32 * nb, scr, 64 * kb, 32 * nb, lane); }
        }
    }
}
constexpr int N_PHASES = 17;
__global__ void __launch_bounds__(NTHR, 2) mk_fwd(Args args) {
    extern __shared__ __attribute__((aligned(16))) unsigned char lds_raw[];
    LAS unsigned char* lds = (LAS unsigned char*)lds_raw;
    volatile LAS unsigned* MISC = (volatile LAS unsigned*)(lds + MISC_OFF);
    const int tid = threadIdx.x, lane = tid & 63, wave = __builtin_amdgcn_readfirstlane(tid >> 6);
    const int G = gridDim.x, bx = blockIdx.x;
    unsigned char* ws = args.ws; float* out = args.li ? (float*)(ws + 16 * MiB) - O_SHP : args.out;
    unsigned* ctl = (unsigned*)(ws + WS_CTL);
    if (tid < 64) MISC[tid] = 0u;
    __syncthreads();
    XcdBarrier bar; bar.bar = ctl + CW_BAR; bar.x = 0; bar.st = nullptr;
#if !MK_PER_PHASE
    bar = xcd_barrier_post(ctl + CW_BAR, MISC + 8);
#define GRID_BAR() xcd_barrier(bar)
#else
#define GRID_BAR() do {} while (0)
#endif
    const int lo = args.ph_lo, hi = args.ph_hi;
#define IN(k) (lo <= (k) && (k) < hi)
#define SEAM(k) do { if (IN(k) && IN((k) + 1)) GRID_BAR(); } while (0)
    const float* x_prompt = args.in[0]; const float* x_sample = args.in[1]; const float* mem_prompt = args.in[2];
    const float* state_hgrn = args.in[3]; const float* state_conv = args.in[4]; const float* cache_k = args.in[5]; const float* cache_v = args.in[6];
    bf16* Wgu1 = (bf16*)(ws + WS_WGU1); bf16* Wd1 = (bf16*)(ws + WS_WD1); bf16* Win = (bf16*)(ws + WS_WIN); bf16* Wout = (bf16*)(ws + WS_WOUT);
    bf16* Wq = (bf16*)(ws + WS_WQ); bf16* Wkv = (bf16*)(ws + WS_WKV); bf16* Wo = (bf16*)(ws + WS_WO); bf16* Wgu2 = (bf16*)(ws + WS_WGU2); bf16* Wd2 = (bf16*)(ws + WS_WD2);
    bf16* XA = (bf16*)(ws + WS_XA); bf16* MN = (bf16*)(ws + WS_MN); float* X = (float*)(ws + WS_X); bf16* H = (bf16*)(ws + WS_H);
    bf16* QH = (bf16*)(ws + WS_QH); bf16* VH = (bf16*)(ws + WS_VH); bf16* GH = (bf16*)(ws + WS_GH); float* LOGF = (float*)(ws + WS_LOGF);
    float* SS = (float*)(ws + WS_SS); float* U = (float*)(ws + WS_U); bf16* OB = (bf16*)(ws + WS_OB); float* DS = (float*)(ws + WS_DS); bf16* SST = (bf16*)(ws + WS_SST); float* DEC = (float*)(ws + WS_DEC);
    bf16* KB = (bf16*)(ws + WS_KB); bf16* VB = (bf16*)(ws + WS_VB); bf16* QB = (bf16*)(ws + WS_QB); bf16* AO = (bf16*)(ws + WS_AO);
    const int gw = bx * NWAVES + wave, NGW = G * NWAVES;

    if (IN(0)) {
        for (int seg = 0; seg < 4; ++seg) convert_items(args, ws, lds, seg, gw, NGW, wave, lane);
        for (int m = gw; m < MT; m += NGW) { const float* src = m < MP ? x_prompt + (size_t)m * DM : x_sample + (size_t)(m - MP) * DM; rms_row_bf16(src, args.in[7], XA + (size_t)m * DM, X + (size_t)m * DM, lane); }
        for (int m = gw; m < MS; m += NGW) rms_row_bf16(mem_prompt + (size_t)m * DM, args.in[21], MN + (size_t)m * DM, nullptr, lane);
    }
    SEAM(0);
    if (IN(1)) {
        { pg8::Gemm g{XA, Wgu1, MT, 2 * DFF, DM}; pg8::SplitOrder S; S.init(MT, 2 * DFF, G, bx, DM); EpiSwiGLU E{H, DFF, (bf16*)DS, nullptr};
          pg8::gemm_phase<EpiSwiGLU, pg8::SplitOrder, true, true>(lds + RING_OFF, g, S, E); }
    }
    SEAM(1);
    if (IN(2)) { swiglu_fixup((const bf16*)DS, H, nullptr, G, bx * NTHR + tid, G * NTHR); if (hi - lo > 1) GRID_BAR();
        pg8::Gemm g{H, Wd1, MT, DM, DFF}; pg8::SplitOrder S; S.init(MT, DM, G, bx, DFF); EpiResid E{X, DM, 0.5f, DS, XA, SS};
        pg8::gemm_phase<EpiResid, pg8::SplitOrder, true, true>(lds + RING_OFF, g, S, E); }
    SEAM(2);
    if (IN(3)) { resid_fixup<8>(X, XA, SS, DS, DFF, G, gw, NGW, lane); }
    SEAM(3);
    if (IN(4)) { pg8::Gemm g{XA, Win, MT, DIN, DM}; pg8::StaticOrder S; S.init(MT, DIN, G, bx, DM); EpiWin E{QH, VH, GH, LOGF, U, args.in[13], SS};
        pg8::gemm_phase<EpiWin, pg8::StaticOrder, true, true>(lds + RING_OFF, g, S, E);
        { pg8::Gemm g{MN, Wkv, MS, 2 * XDIM, DM}; pg8::StaticOrder S; S.init(MS, 2 * XDIM, G, (bx + G - 96) % G, DM); EpiKV E{out + O_MKP, out + O_MVP, KB, VB};
          pg8::gemm_phase<EpiKV, pg8::StaticOrder, true, true>(lds + RING_OFF, g, S, E); }
    }
    SEAM(4);
    if (IN(5) || IN(17)) { hgrn_chunk_states(lds, LOGF, VH, DS, DEC, bx, 1024, G, tid); }
    if (IN(5) || IN(18)) { hgrn_samples(lds, LOGF, QH, VH, GH, state_hgrn, out + O_SHS, args.in[14], OB, bx, 1024, G, tid); }
    if (IN(5) || IN(19)) {
        conv_tasks<false>(lds, U, state_conv, args.in[15], args.in[16], args.in[17], args.in[18], OB, bx, 1024, G, tid);
        conv_tasks<true>(lds, U, state_conv, args.in[15], args.in[16], args.in[17], args.in[18], OB, 1024 + bx, 1152, G, tid);
        const int gt = bx * NTHR + tid, NGT = G * NTHR;
        for (int i = gt; i < 4 * 30 * 256; i += NGT) { const int n = i / 7680, rem = i % 7680, r = rem >> 8, c4 = rem & 255;
            *(f32x4*)(out + O_SCP + (size_t)i * 4) = *(const f32x4*)(U + ((size_t)(n * 2048 + 2018 + r)) * 1024 + 4 * c4); }
        for (int i = gt; i < 128 * 30 * 256; i += NGT) { const int n = i / 7680, rem = i % 7680, r = rem >> 8, c4 = rem & 255;
            const float* src = r < 22 ? state_conv + ((size_t)(n * 30 + 8 + r)) * 1024 + 4 * c4 : U + ((size_t)(MP + n * 8 + r - 22)) * 1024 + 4 * c4;
            __builtin_nontemporal_store(__builtin_nontemporal_load((const f32x4*)src), (f32x4*)(out + O_SCS + (size_t)i * 4)); }
    }
    SEAM(5);
    if (IN(6)) {
        const int gt = bx * NTHR + tid, NGT = G * NTHR;
        for (int i = gt; i < 32 * 4096; i += NGT) { const int nh = i >> 12, q4 = i & 4095, d = q4 >> 5, e4 = q4 & 31; f32x4 S = (f32x4){0.f, 0.f, 0.f, 0.f};
#pragma unroll 16
            for (int c = 0; c < 32; ++c) { const size_t task = (size_t)nh * 32 + c; u32x2 w; w.x = cvt_pk_bf16(S[0], S[1]); w.y = cvt_pk_bf16(S[2], S[3]);
                *(u32x2*)(SST + task * 16384 + d * 128 + 4 * e4) = w;
                const f32x4 dc = *(const f32x4*)(DEC + task * 128 + 4 * e4), ds = *(const f32x4*)(DS + task * 16384 + d * 128 + 4 * e4); S = dc * S + ds; }
#pragma unroll
            for (int k = 0; k < 4; ++k) out[O_SHP + (size_t)nh * 16384 + (4 * e4 + k) * 128 + d] = S[k]; }
    }
    SEAM(6);
    if (IN(7)) { hgrn_chunk_outs(lds, LOGF, QH, VH, GH, SST, args.in[14], OB, bx, 1024, G, tid); }
    SEAM(7);
    if (IN(8)) { pg8::Gemm g{OB, Wout, MT, DM, DM}; pg8::SplitOrder S; S.init(MT, DM, G, bx, DM); EpiResid E{X, DM, 1.0f, DS, XA, SS + MT};
        pg8::gemm_phase<EpiResid, pg8::SplitOrder, true, true>(lds + RING_OFF, g, S, E); }
    SEAM(8);
    if (IN(9)) { resid_fixup<8>(X, XA, SS + MT, DS, DM, G, gw, NGW, lane); }
    SEAM(9);
    if (IN(10)) { pg8::Gemm g{XA, Wq, MT, XDIM, DM}; pg8::SplitOrder S; S.init(MT, XDIM, G, bx, DM); EpiResid E{nullptr, 0, 0.08838834764831845f, DS, nullptr, nullptr};
        pg8::gemm_phase<EpiResid, pg8::SplitOrder, true, true>(lds + RING_OFF, g, S, E);
    }
    SEAM(10);
    if (IN(11)) {
        { pg8::SplitOrder S; S.init(MT, XDIM, G, 0, DM);
          const int gt = bx * NTHR + tid, NGT = G * NTHR;
          for (int item = gt; item < S.R * 8192; item += NGT) { const int r = item >> 13, row = (item >> 5) & 255, c8 = item & 31; pg8::Unit u; S.tile_of(S.F * G + r, u);
              float a[8];
#pragma unroll
              for (int i = 0; i < 8; ++i) a[i] = 0.f;
              const bf16* sp = (const bf16*)DS + ((size_t)r * S.ns * 256 + row) * 256 + 8 * c8;
              v4u w3[3];
#pragma unroll
              for (int q = 0; q < 3; ++q) w3[q] = *(const v4u*)(sp + (size_t)(q < S.ns ? q : 0) * 65536);
              for (int q3 = 3; q3 < S.ns; ++q3) { const v4u w = *(const v4u*)(sp + (size_t)q3 * 65536); const unsigned ww[4] = {w.x, w.y, w.z, w.w};
#pragma unroll
                  for (int i = 0; i < 4; ++i) { a[2 * i] += __builtin_bit_cast(float, ww[i] << 16); a[2 * i + 1] += __builtin_bit_cast(float, ww[i] & 0xffff0000u); } }
#pragma unroll
              for (int q = 0; q < 3; ++q) { if (q >= S.ns) continue; const v4u w = w3[q]; const unsigned ww[4] = {w.x, w.y, w.z, w.w};
#pragma unroll
                  for (int i = 0; i < 4; ++i) { a[2 * i] += __builtin_bit_cast(float, ww[i] << 16); a[2 * i + 1] += __builtin_bit_cast(float, ww[i] & 0xffff0000u); } }
              { const float rs = 1.f / sqrtf(SS[MT + u.pm * 256 + row] * (1.f / DM) + EPS);
#pragma unroll
                for (int i = 0; i < 8; ++i) a[i] *= rs; }
              v4u o; o.x = cvt_pk_bf16(a[0], a[1]); o.y = cvt_pk_bf16(a[2], a[3]); o.z = cvt_pk_bf16(a[4], a[5]); o.w = cvt_pk_bf16(a[6], a[7]);
              *(v4u*)(QB + (size_t)(u.pm * 256 + row) * XDIM + u.pn * 256 + 8 * c8) = o; }
          if (hi - lo > 1) GRID_BAR(); }
        for (int u = bx; u < 256; u += G) attn_unit(lds, QB, KB, VB, AO, u, tid);
        attn_samples(lds, QB, cache_k, cache_v, AO, bx, 512, G, tid); }
    SEAM(11);
    if (IN(12)) { pg8::Gemm g{AO, Wo, MT, DM, XDIM}; pg8::SplitOrder S; S.init(MT, DM, G, bx, XDIM); EpiResid E{X, DM, 1.0f, DS, XA, SS + 2 * MT};
        pg8::gemm_phase<EpiResid, pg8::SplitOrder, true, true>(lds + RING_OFF, g, S, E); }
    SEAM(12);
    if (IN(13)) { resid_fixup<2>(X, XA, SS + 2 * MT, DS, XDIM, G, gw, NGW, lane); }
    SEAM(13);
    if (IN(14)) { pg8::Gemm g{XA, Wgu2, MT, 2 * DFF, DM}; pg8::SplitOrder S; S.init(MT, 2 * DFF, G, bx, DM); EpiSwiGLU E{H, DFF, (bf16*)DS, SS + 2 * MT};
        pg8::gemm_phase<EpiSwiGLU, pg8::SplitOrder, true, true>(lds + RING_OFF, g, S, E); }
    SEAM(14);
    if (IN(15)) { swiglu_fixup((const bf16*)DS, H, SS + 2 * MT, G, bx * NTHR + tid, G * NTHR); if (hi - lo > 1) GRID_BAR();
        pg8::Gemm g{H, Wd2, MT, DM, DFF}; pg8::SplitOrder S; S.init(MT, DM, G, bx, DFF); EpiResid E{X, DM, 0.5f, DS, nullptr, nullptr};
        pg8::gemm_phase<EpiResid, pg8::SplitOrder, true, true>(lds + RING_OFF, g, S, E); }
    SEAM(15);
    if (IN(16)) { LAS int* T = (LAS int*)lds; build_split_table(T, G, tid); { f32x4 nx[8];
          if (gw < MT) {
#pragma unroll
              for (int j = 0; j < 8; ++j) nx[j] = ((const f32x4*)(X + (size_t)gw * DM) + lane)[64 * j]; }
          for (int m = gw; m < MT; m += NGW) { f32x4 v[8];
#pragma unroll
              for (int j = 0; j < 8; ++j) v[j] = nx[j];
              if (m + NGW < MT) {
#pragma unroll
                  for (int j = 0; j < 8; ++j) nx[j] = ((const f32x4*)(X + (size_t)(m + NGW) * DM) + lane)[64 * j]; }
              __builtin_amdgcn_sched_barrier(0);
              rms_row_final(v, args.in[30], out + O_Y + (size_t)m * DM, T, DS, 8, m, lane); } } }
#undef IN
#undef SEAM
}

extern "C" void kernel_launch(void* const* d_in, const int* in_sizes, int n_in, void* d_out, int out_size, void* d_ws, size_t ws_size, hipStream_t stream) {
    static int grid = 0;
    if (grid == 0) {
        if (n_in != 31 || (size_t)out_size != O_END || ws_size < WS_END) { fprintf(stderr, "kernel_launch: unexpected sizes n_in %d out %d ws %zu\n", n_in, out_size, ws_size); grid = -1; return; }
        int dev = 0, cus = 0, per_cu = 0;
        if (hipGetDevice(&dev) != hipSuccess || hipDeviceGetAttribute(&cus, hipDeviceAttributeMultiprocessorCount, dev) != hipSuccess) { grid = -1; return; }
        if (hipFuncSetAttribute((const void*)mk_fwd, hipFuncAttributeMaxDynamicSharedMemorySize, LDS_BYTES) != hipSuccess) { fprintf(stderr, "kernel_launch: hipFuncSetAttribute failed\n"); grid = -1; return; }
        if (hipOccupancyMaxActiveBlocksPerMultiprocessor(&per_cu, (const void*)mk_fwd, NTHR, LDS_BYTES) != hipSuccess || per_cu < 1) { fprintf(stderr, "kernel_launch: occupancy query says %d\n", per_cu); (void)hipGetLastError(); grid = -1; return; }
        grid = cus;
    }
    if (grid < 0) return;
    if (hipMemsetAsync((char*)d_ws + WS_CTL, 0, CTL_ZERO_BYTES, stream) != hipSuccess) return;
    Args a{};
    for (int i = 0; i < 31; ++i) a.in[i] = (const float*)d_in[i];
    a.out = (float*)d_out; a.ws = (unsigned char*)d_ws;
#if MK_PER_PHASE
    for (int p = 0; p < N_PHASES; ++p) { a.ph_lo = p; a.ph_hi = p + 1; a.li = p; hipLaunchKernelGGL(mk_fwd, dim3(grid), dim3(NTHR), LDS_BYTES, stream, a); }
#else
    a.ph_lo = 0; a.ph_hi = N_PHASES; a.li = 0;
    hipLaunchKernelGGL(mk_fwd, dim3(grid), dim3(NTHR), LDS_BYTES, stream, a);
#ifdef PROBE_MASK
    for (int p = 0; p < 24; ++p) if ((PROBE_MASK >> p) & 1) { a.ph_lo = p; a.ph_hi = p + 1; a.li = (p == 16) ? 0 : 1; hipLaunchKernelGGL(mk_fwd, dim3(grid), dim3(NTHR), LDS_BYTES, stream, a); }
#endif
#endif
}
```
